# Optimizing an MI355X kernel written in HIP

```python
import math
import jax, jax.numpy as jnp
from jax import lax
import numpy as np

D_MODEL = 2048
BATCH = 16
SEQ = 256
DEPTH = 4
DEC_BATCH = 2
DEC_SEQ = 2048
PAST_LEN = 256

GRID_W = 64
N_MIXERS = 2
N_WIN_LAYERS = (DEPTH + 1) // 2
N_MLA_LAYERS = DEPTH // 2
WIN_HEADS = 32
WIN_KV_HEADS = 8
WIN_GROUP = WIN_HEADS // WIN_KV_HEADS
WIN_HEAD_DIM = 64
WINDOW = 128
BLOCK = WINDOW
WIN_SCALE = WIN_HEAD_DIM ** -0.5
MLA_HEADS = 16
Q_LORA_RANK = 512
KV_LORA_RANK = 512
QK_NOPE_DIM = 128
QK_ROPE_DIM = 64
V_HEAD_DIM = 128
MLA_SCALE = (QK_NOPE_DIM + QK_ROPE_DIM) ** -0.5
D_FF = -(-8 * D_MODEL // (3 * 256)) * 256
ROPE_BASE = 10000.0
EPS = 1e-6
NEG = float(np.finfo(np.float32).min)

kernel_name = "hybrid_dit_prefix_window_mla_step"


def rms_norm(x, g):
    xf = x.astype(jnp.float32)
    y = xf * lax.rsqrt(jnp.mean(xf * xf, axis=-1, keepdims=True) + EPS)
    return (y * g.astype(jnp.float32)).astype(x.dtype)


def ada_modulation(cond, w_ada, b_ada):
    m = jax.nn.silu(cond) @ w_ada + b_ada
    return jnp.split(m[:, None, :], 6, axis=-1)


def modulate(x, g, shift, scale):
    return rms_norm(x, g) * (1 + scale) + shift


def grid_positions(n_tokens):
    n_rows = n_tokens // GRID_W
    rows = jnp.broadcast_to(jnp.arange(n_rows, dtype=jnp.int32)[:, None], (n_rows, GRID_W)).reshape(-1)
    cols = jnp.broadcast_to(jnp.arange(GRID_W, dtype=jnp.int32)[None, :], (n_rows, GRID_W)).reshape(-1)
    return rows, cols


def rope_angles(pos, dim):
    half = dim // 2
    freqs = ROPE_BASE ** (-jnp.arange(half, dtype=jnp.float32) / half)
    ang = pos.astype(jnp.float32)[:, None] * freqs[None, :]
    return jnp.cos(ang), jnp.sin(ang)


def rope_1d(x, cos, sin):
    half = x.shape[-1] // 2
    x1, x2 = x[..., :half], x[..., half:]
    c = cos[:, None, :].astype(x.dtype)
    s = sin[:, None, :].astype(x.dtype)
    return jnp.concatenate([x1 * c - x2 * s, x1 * s + x2 * c], axis=-1)


def rope_2d(x, rows, cols):
    half = x.shape[-1] // 2
    cr, sr = rope_angles(rows, half)
    cc, sc = rope_angles(cols, half)
    return jnp.concatenate([rope_1d(x[..., :half], cr, sr), rope_1d(x[..., half:], cc, sc)], axis=-1)


def sink_softmax(logits, sink_logit):
    sink = jnp.broadcast_to(sink_logit, logits.shape[:-1] + (1,))
    p = jax.nn.softmax(jnp.concatenate([logits, sink], axis=-1), axis=-1)
    return p[..., :-1]


def win_qkv(h, w_qkv):
    B, L, _ = h.shape
    qd, kd = WIN_HEADS * WIN_HEAD_DIM, WIN_KV_HEADS * WIN_HEAD_DIM
    q, k, v = jnp.split(h @ w_qkv, [qd, qd + kd], axis=-1)
    return (q.reshape(B, L, WIN_HEADS, WIN_HEAD_DIM),
            k.reshape(B, L, WIN_KV_HEADS, WIN_HEAD_DIM),
            v.reshape(B, L, WIN_KV_HEADS, WIN_HEAD_DIM))


def win_attn_context(h, w_qkv, w_o, sink):
    B, L, _ = h.shape
    q, k, v = win_qkv(h, w_qkv)
    q = q.reshape(B, L, WIN_KV_HEADS, WIN_GROUP, WIN_HEAD_DIM)
    logits = jnp.einsum('bqkgd,bskd->bkgqs', q, k).astype(jnp.float32) * WIN_SCALE
    p = sink_softmax(logits, sink.reshape(WIN_KV_HEADS, WIN_GROUP)[None, :, :, None, None].astype(jnp.float32))
    o = jnp.einsum('bkgqs,bskd->bqkgd', p.astype(v.dtype), v).reshape(B, L, WIN_HEADS * WIN_HEAD_DIM)
    return o @ w_o, k, v


def win_attn_latent(h, ctx_k, ctx_v, rows, cols, w_qkv, w_o, sink):
    B, L, _ = h.shape
    nb = L // BLOCK
    q, k, v = win_qkv(h, w_qkv)
    q = rope_2d(q, rows, cols).reshape(B, nb, BLOCK, WIN_KV_HEADS, WIN_GROUP, WIN_HEAD_DIM)
    k = rope_2d(k, rows, cols)
    pad = ((0, 0), (WINDOW, WINDOW), (0, 0), (0, 0))
    kb = jnp.pad(k, pad).reshape(B, nb + 2, BLOCK, WIN_KV_HEADS, WIN_HEAD_DIM)
    vb = jnp.pad(v, pad).reshape(B, nb + 2, BLOCK, WIN_KV_HEADS, WIN_HEAD_DIM)
    kw = jnp.concatenate([kb[:, :-2], kb[:, 1:-1], kb[:, 2:]], axis=2)
    vw = jnp.concatenate([vb[:, :-2], vb[:, 1:-1], vb[:, 2:]], axis=2)
    blk_start = (jnp.arange(nb) * BLOCK)[:, None, None]
    key_pos = blk_start - WINDOW + jnp.arange(3 * BLOCK)[None, None, :]
    qry_pos = blk_start + jnp.arange(BLOCK)[None, :, None]
    valid = (jnp.abs(key_pos - qry_pos) <= WINDOW) & (key_pos >= 0) & (key_pos < L)
    lw = jnp.einsum('bnqkgd,bnskd->bnkgqs', q, kw).astype(jnp.float32) * WIN_SCALE
    lw = jnp.where(valid[None, :, None, None, :, :], lw, NEG)
    lc = jnp.einsum('bnqkgd,bckd->bnkgqc', q, ctx_k).astype(jnp.float32) * WIN_SCALE
    p = sink_softmax(jnp.concatenate([lw, lc], axis=-1),
                     sink.reshape(WIN_KV_HEADS, WIN_GROUP)[None, None, :, :, None, None].astype(jnp.float32))
    pw = p[..., :3 * BLOCK].astype(v.dtype)
    pc = p[..., 3 * BLOCK:].astype(v.dtype)
    o = (jnp.einsum('bnkgqs,bnskd->bnqkgd', pw, vw)
         + jnp.einsum('bnkgqc,bckd->bnqkgd', pc, ctx_v))
    return o.reshape(B, L, WIN_HEADS * WIN_HEAD_DIM) @ w_o


def mla_project(h, w_in, q_norm, w_q_b, kv_norm):
    B, L, _ = h.shape
    c_q, c_kv, k_pe = jnp.split(h @ w_in, [Q_LORA_RANK, Q_LORA_RANK + KV_LORA_RANK], axis=-1)
    q = (rms_norm(c_q, q_norm) @ w_q_b).reshape(B, L, MLA_HEADS, QK_NOPE_DIM + QK_ROPE_DIM)
    return q[..., :QK_NOPE_DIM], q[..., QK_NOPE_DIM:], rms_norm(c_kv, kv_norm), k_pe


def mla_expand(c_kv, w_kv_b):
    B, L, _ = c_kv.shape
    kv = (c_kv @ w_kv_b).reshape(B, L, MLA_HEADS, QK_NOPE_DIM + V_HEAD_DIM)
    return kv[..., :QK_NOPE_DIM], kv[..., QK_NOPE_DIM:]


def mla_attn_context(h, w_in, q_norm, w_q_b, kv_norm, w_kv_b, w_o):
    B, L, _ = h.shape
    q_nope, q_pe, c_kv, k_pe = mla_project(h, w_in, q_norm, w_q_b, kv_norm)
    k_nope, v = mla_expand(c_kv, w_kv_b)
    logits = (jnp.einsum('bqhd,bshd->bhqs', q_nope, k_nope)
              + jnp.einsum('bqhr,bsr->bhqs', q_pe, k_pe)).astype(jnp.float32) * MLA_SCALE
    p = jax.nn.softmax(logits, axis=-1).astype(v.dtype)
    o = jnp.einsum('bhqs,bshd->bqhd', p, v).reshape(B, L, MLA_HEADS * V_HEAD_DIM)
    return o @ w_o, c_kv, k_pe


def mla_attn_latent(h, ctx_ckv, ctx_kpe, rows, cols, w_in, q_norm, w_q_b, kv_norm, w_kv_b, w_o):
    B, L, _ = h.shape
    nb = L // BLOCK
    q_nope, q_pe, c_kv, k_pe = mla_project(h, w_in, q_norm, w_q_b, kv_norm)
    q_pe = rope_2d(q_pe, rows, cols)
    k_pe = rope_2d(k_pe[:, :, None, :], rows, cols)[:, :, 0, :]
    k_nope, v = mla_expand(jnp.concatenate([c_kv, ctx_ckv], axis=1), w_kv_b)
    k_pe = jnp.concatenate([k_pe, ctx_kpe], axis=1)
    qn_b = q_nope.reshape(B, nb, BLOCK, MLA_HEADS, QK_NOPE_DIM).transpose(1, 0, 2, 3, 4)
    qp_b = q_pe.reshape(B, nb, BLOCK, MLA_HEADS, QK_ROPE_DIM).transpose(1, 0, 2, 3, 4)

    def attend_block(qb):
        qn, qp = qb
        logits = (jnp.einsum('bqhd,bshd->bhqs', qn, k_nope)
                  + jnp.einsum('bqhr,bsr->bhqs', qp, k_pe)).astype(jnp.float32) * MLA_SCALE
        p = jax.nn.softmax(logits, axis=-1).astype(v.dtype)
        return jnp.einsum('bhqs,bshd->bqhd', p, v)

    o = lax.map(attend_block, (qn_b, qp_b))
    o = o.transpose(1, 0, 2, 3, 4).reshape(B, L, MLA_HEADS * V_HEAD_DIM)
    return o @ w_o


def swiglu(h, w_gate, w_up, w_down):
    return (jax.nn.silu(h @ w_gate) * (h @ w_up)) @ w_down


def setup_inputs(seed: int = 0) -> dict:
    key = jax.random.key(seed)
    ks = iter(jax.random.split(key, 32))

    def nrm(shape, scale):
        return jax.random.normal(next(ks), shape, jnp.float32) * scale

    def gain(shape):
        return 1.0 + nrm(shape, 0.1)

    qkv_w = (WIN_HEADS + 2 * WIN_KV_HEADS) * WIN_HEAD_DIM
    return {
        "x_prompt": nrm((BATCH, SEQ, D_MODEL), 1.0),
        "x_sample": nrm((DEC_BATCH, DEC_SEQ, D_MODEL), 1.0),
        "cache_win_k": nrm((DEC_BATCH, N_WIN_LAYERS, PAST_LEN, WIN_KV_HEADS, WIN_HEAD_DIM), 1.0),
        "cache_win_v": nrm((DEC_BATCH, N_WIN_LAYERS, PAST_LEN, WIN_KV_HEADS, WIN_HEAD_DIM), 1.0),
        "cache_mla_ckv": nrm((DEC_BATCH, N_MLA_LAYERS, PAST_LEN, KV_LORA_RANK), 1.0),
        "cache_mla_kpe": nrm((DEC_BATCH, N_MLA_LAYERS, PAST_LEN, QK_ROPE_DIM), 1.0),
        "c": nrm((DEC_BATCH, D_MODEL), 1.0),
        "c_ctx": nrm((D_MODEL,), 1.0),
        "ada_w": nrm((DEPTH, D_MODEL, 6 * D_MODEL), 0.5 * D_MODEL ** -0.5),
        "ada_b": nrm((DEPTH, 6 * D_MODEL), 0.02),
        "norm_mix": gain((DEPTH, D_MODEL)),
        "norm_ffn": gain((DEPTH, D_MODEL)),
        "win_w_qkv": nrm((N_WIN_LAYERS, D_MODEL, qkv_w), D_MODEL ** -0.5),
        "win_w_o": nrm((N_WIN_LAYERS, WIN_HEADS * WIN_HEAD_DIM, D_MODEL), (WIN_HEADS * WIN_HEAD_DIM) ** -0.5),
        "win_sink": nrm((N_WIN_LAYERS, WIN_HEADS), 0.5),
        "mla_w_in": nrm((N_MLA_LAYERS, D_MODEL, Q_LORA_RANK + KV_LORA_RANK + QK_ROPE_DIM), D_MODEL ** -0.5),
        "mla_q_norm": gain((N_MLA_LAYERS, Q_LORA_RANK)),
        "mla_w_q_b": nrm((N_MLA_LAYERS, Q_LORA_RANK, MLA_HEADS * (QK_NOPE_DIM + QK_ROPE_DIM)), Q_LORA_RANK ** -0.5),
        "mla_kv_norm": gain((N_MLA_LAYERS, KV_LORA_RANK)),
        "mla_w_kv_b": nrm((N_MLA_LAYERS, KV_LORA_RANK, MLA_HEADS * (QK_NOPE_DIM + V_HEAD_DIM)), KV_LORA_RANK ** -0.5),
        "mla_w_o": nrm((N_MLA_LAYERS, MLA_HEADS * V_HEAD_DIM, D_MODEL), (MLA_HEADS * V_HEAD_DIM) ** -0.5),
        "ffn_w_gate": nrm((DEPTH, D_MODEL, D_FF), D_MODEL ** -0.5),
        "ffn_w_up": nrm((DEPTH, D_MODEL, D_FF), D_MODEL ** -0.5),
        "ffn_w_down": nrm((DEPTH, D_FF, D_MODEL), D_FF ** -0.5),
        "norm_final": gain((D_MODEL,)),
    }


def reference(x_prompt, x_sample, cache_win_k, cache_win_v, cache_mla_ckv, cache_mla_kpe, c,
              c_ctx, ada_w, ada_b, norm_mix, norm_ffn, win_w_qkv, win_w_o, win_sink,
              mla_w_in, mla_q_norm, mla_w_q_b, mla_kv_norm, mla_w_kv_b, mla_w_o,
              ffn_w_gate, ffn_w_up, ffn_w_down, norm_final):
    rows, cols = grid_positions(x_sample.shape[1])
    xc, xs = x_prompt, x_sample
    win_k_out, win_v_out, ckv_out, kpe_out = [], [], [], []
    for layer in range(DEPTH):
        j = layer // N_MIXERS
        sh_mc, sc_mc, g_mc, sh_fc, sc_fc, g_fc = ada_modulation(c_ctx[None, :], ada_w[layer], ada_b[layer])
        sh_ms, sc_ms, g_ms, sh_fs, sc_fs, g_fs = ada_modulation(c, ada_w[layer], ada_b[layer])
        hc = modulate(xc, norm_mix[layer], sh_mc, sc_mc)
        hs = modulate(xs, norm_mix[layer], sh_ms, sc_ms)
        if layer % N_MIXERS == 0:
            oc, k_ctx, v_ctx = win_attn_context(hc, win_w_qkv[j], win_w_o[j], win_sink[j])
            os_ = win_attn_latent(hs, cache_win_k[:, j], cache_win_v[:, j], rows, cols,
                                  win_w_qkv[j], win_w_o[j], win_sink[j])
            win_k_out.append(k_ctx)
            win_v_out.append(v_ctx)
        else:
            oc, ckv_ctx, kpe_ctx = mla_attn_context(hc, mla_w_in[j], mla_q_norm[j], mla_w_q_b[j],
                                                    mla_kv_norm[j], mla_w_kv_b[j], mla_w_o[j])
            os_ = mla_attn_latent(hs, cache_mla_ckv[:, j], cache_mla_kpe[:, j], rows, cols,
                                  mla_w_in[j], mla_q_norm[j], mla_w_q_b[j],
                                  mla_kv_norm[j], mla_w_kv_b[j], mla_w_o[j])
            ckv_out.append(ckv_ctx)
            kpe_out.append(kpe_ctx)
        xc = xc + g_mc * oc
        xs = xs + g_ms * os_
        hc = modulate(xc, norm_ffn[layer], sh_fc, sc_fc)
        hs = modulate(xs, norm_ffn[layer], sh_fs, sc_fs)
        xc = xc + g_fc * swiglu(hc, ffn_w_gate[layer], ffn_w_up[layer], ffn_w_down[layer])
        xs = xs + g_fs * swiglu(hs, ffn_w_gate[layer], ffn_w_up[layer], ffn_w_down[layer])
    y_prompt = rms_norm(xc, norm_final)
    y_sample = rms_norm(xs, norm_final)
    new_win_k = jnp.stack(win_k_out, axis=1)
    new_win_v = jnp.stack(win_v_out, axis=1)
    new_mla_ckv = jnp.stack(ckv_out, axis=1)
    new_mla_kpe = jnp.stack(kpe_out, axis=1)
    return (y_prompt, y_sample, new_win_k, new_win_v, new_mla_ckv, new_mla_kpe)
```

```cpp
#include <hip/hip_runtime.h>
#include <cstdio>
#include <cstdint>
namespace pg8 {
#define PG8_LAS __attribute__((address_space(3)))
typedef unsigned short bf16_t;
typedef short bf16x8 __attribute__((ext_vector_type(8)));
typedef float f32x4 __attribute__((ext_vector_type(4)));
typedef unsigned u32x4 __attribute__((ext_vector_type(4)));
constexpr int BM = 256, BK = 64, HALF = 128, HTB = HALF * BK * 2  , STAGE_BYTES = 8 * HTB, NXCD = 8, WGM = 8;

__host__ __device__ __forceinline__ int lds_byte(int r, int c) { const int st = (r >> 4) * 2 + (c >> 5), rr = r & 15, cc = c & 31, ob = rr * 64 + cc * 2; return st * 1024 + (ob ^ (((ob >> 9) & 1) << 5)); }
__host__ __device__ __forceinline__ void stage_rc(int b, int& R, int& C) { const int st = b / 1024, sb = b % 1024, swz = sb ^ (((sb >> 9) & 1) << 5); R = (st >> 1) * 16 + swz / 64; C = (st & 1) * 32 + (swz % 64) / 2; }
__host__ __device__ __forceinline__ int perm32(int rho) { const int n = rho >> 4, i = rho & 15; return 8 * (i >> 2) + 4 * n + (i & 3); }

struct Unit { int pm, pn; };
struct Gemm { const bf16_t* A; const bf16_t* Bt; int M, N, K; };

struct StaticOrder {
    int nM, nN, nwg, G, c;
    __host__ __device__ void init(int M, int N, int G_, int c_) { nM = M / BM; nN = N / BM; nwg = nM * nN; G = G_; c = c_; }
    __host__ __device__ bool next(int i, Unit& u) const {
        const long L = (long)i * G + c; if (L >= nwg) return false;
        int wgid = (int)L; { const int q = nwg / NXCD, r = nwg % NXCD, xcd = wgid % NXCD, off = wgid / NXCD; wgid = (xcd < r ? xcd * (q + 1) : r * (q + 1) + (xcd - r) * q) + off; }
        const int nig = WGM * nN, gid = wgid / nig, fm = gid * WGM, gsz = (nM - fm) < WGM ? (nM - fm) : WGM;
        u.pm = fm + ((wgid % nig) % gsz); u.pn = (wgid % nig) / gsz; return true;
    }
    __device__ __forceinline__ void a_ready(const Unit&) const {}
    __device__ __forceinline__ void done(const Unit&) const {}
};

__device__ __forceinline__ unsigned cvt_pk_bf16(float lo, float hi) { unsigned r; asm volatile("v_cvt_pk_bf16_f32 %0, %1, %2" : "=v"(r) : "v"(lo), "v"(hi)); return r; }
typedef float f32x2 __attribute__((ext_vector_type(2)));
template <class Epi, class Sched, bool ALIGN_EPI = false, bool SP2 = false>
__device__ __forceinline__ void gemm_phase(PG8_LAS unsigned char* lds, const Gemm g, const Sched& S, const Epi& E) {
    int tid_ = threadIdx.x; asm volatile("" : "+v"(tid_));
    const int tid = tid_, wid = __builtin_amdgcn_readfirstlane(tid >> 6), lane = tid & 63, wr = wid >> 2, wc = wid & 3, fr = lane & 15, fq = lane >> 4;
    const int K = g.K, nt = K / BK;
    unsigned voffA[2], voffB[2];
#pragma unroll
    for (int i = 0; i < 2; ++i) { int R, C; stage_rc(tid * 16 + i * 8192, R, C); const int Rb = Epi::PERM ? ((R & ~31) + perm32(R & 31)) : R;
        voffA[i] = (unsigned)(R * K + C) * 2u; voffB[i] = (unsigned)(Rb * K + C) * 2u; }
    const size_t kstep = (size_t)(BK * 2);
    const size_t hstep = (size_t)HALF * K * 2;
    const size_t tstep = 2 * hstep;
    const unsigned ldsw = (unsigned)wid * 1024u;
    const int aoff = lds_byte(wr * 64 + fr, fq * 8), boff = lds_byte(wc * 32 + fr, fq * 8);
#define PG8_SA(b, h) (((b) * 2 + (h)) * HTB)
#define PG8_SB(b, h) ((4 + (b) * 2 + (h)) * HTB)
#define PG8_STAGE(bufoff, gbase, voff) do { _Pragma("unroll") for (int _i = 0; _i < 2; ++_i) \
        __builtin_amdgcn_global_load_lds((const unsigned*)((const char*)(gbase) + (voff)[_i]), (PG8_LAS unsigned*)(lds + (bufoff) + ldsw + _i * 8192), 16, 0, 0); } while (0)
#define PG8_LDA(dst, b, h) do { _Pragma("unroll") for (int m = 0; m < 4; ++m) _Pragma("unroll") for (int k = 0; k < 2; ++k) dst[m][k] = *(const PG8_LAS bf16x8*)(lds + PG8_SA(b, h) + aoff + m * 2048 + k * 1024); } while (0)
#define PG8_LDB(dst, b, h) do { _Pragma("unroll") for (int n = 0; n < 2; ++n) _Pragma("unroll") for (int k = 0; k < 2; ++k) dst[n][k] = *(const PG8_LAS bf16x8*)(lds + PG8_SB(b, h) + boff + n * 2048 + k * 1024); } while (0)
#define PG8_MMA(ai, bj, At, Bt) do { __builtin_amdgcn_s_setprio(1); _Pragma("unroll") for (int m = 0; m < 4; ++m) _Pragma("unroll") for (int n = 0; n < 2; ++n) _Pragma("unroll") for (int k = 0; k < 2; ++k) \
        acc[ai][bj][m][n] = __builtin_amdgcn_mfma_f32_16x16x32_bf16(Bt[n][k], At[m][k], acc[ai][bj][m][n], 0, 0, 0); __builtin_amdgcn_s_setprio(0); } while (0)
#define PG8_WAIT_V(n) asm volatile("s_waitcnt vmcnt(" #n ")" ::: "memory")
#define PG8_WAIT_L(n) asm volatile("s_waitcnt lgkmcnt(" #n ")" ::: "memory")
#define PG8_BAR __builtin_amdgcn_s_barrier()
#define PG8_SCHED __builtin_amdgcn_sched_barrier(0)
    Unit cur, nxt; int ui = 0;
    if (!S.next(0, cur)) return;
    f32x4 acc[2][2][4][2];
#pragma unroll
    for (int a = 0; a < 2; ++a)
#pragma unroll
        for (int b = 0; b < 2; ++b)
#pragma unroll
            for (int m = 0; m < 4; ++m)
#pragma unroll
                for (int n = 0; n < 2; ++n) acc[a][b][m][n] = (f32x4){0.f, 0.f, 0.f, 0.f};
    bf16x8 At[4][2], B0[2][2], B1[2][2];
    const char* cA = (const char*)g.A + (size_t)cur.pm * tstep; const char* cB = (const char*)g.Bt + (size_t)cur.pn * tstep;
    S.a_ready(cur);
    if constexpr (SP2) {
        PG8_STAGE(PG8_SB(0, 0), cB, voffB); PG8_STAGE(PG8_SB(0, 1), cB + hstep, voffB); PG8_STAGE(PG8_SA(0, 0), cA, voffA); PG8_STAGE(PG8_SA(0, 1), cA + hstep, voffA);
        if (wr == 1) PG8_BAR;
        PG8_WAIT_V(2); PG8_BAR;
        PG8_STAGE(PG8_SB(1, 0), cB + kstep, voffB); PG8_STAGE(PG8_SA(1, 0), cA + kstep, voffA); PG8_STAGE(PG8_SB(1, 1), cB + hstep + kstep, voffB);
        PG8_WAIT_V(6); PG8_BAR;
    } else {
        PG8_STAGE(PG8_SB(0, 0), cB, voffB); PG8_STAGE(PG8_SA(0, 0), cA, voffA); PG8_STAGE(PG8_SB(0, 1), cB + hstep, voffB); PG8_STAGE(PG8_SA(0, 1), cA + hstep, voffA);
        if (wr == 1) PG8_BAR;
        PG8_WAIT_V(4); PG8_BAR;
        PG8_STAGE(PG8_SB(1, 0), cB + kstep, voffB); PG8_STAGE(PG8_SA(1, 0), cA + kstep, voffA); PG8_STAGE(PG8_SB(1, 1), cB + hstep + kstep, voffB);
        PG8_WAIT_V(6); PG8_BAR;
    }
    for (;;) {
        const bool has_next = S.next(ui + 1, nxt);
        const char* nA = has_next ? (const char*)g.A + (size_t)nxt.pm * tstep : cA; const char* nB = has_next ? (const char*)g.Bt + (size_t)nxt.pn * tstep : cB;
        for (int t = 0; t < nt; t += 2) {
            const bool last = (t == nt - 2);
            const char* a1 = cA + (size_t)(t + 1) * kstep;
            const char* a2 = last ? nA : cA + (size_t)(t + 2) * kstep; const char* b2 = last ? nB : cB + (size_t)(t + 2) * kstep;
            const char* a3 = a2 + kstep; const char* b3 = b2 + kstep;
            if (last && has_next) S.a_ready(nxt);
            if constexpr (SP2) {
            PG8_LDB(B0, 0, 0); PG8_LDB(B1, 0, 1); PG8_SCHED; PG8_LDA(At, 0, 0); PG8_STAGE(PG8_SA(1, 1), a1 + hstep, voffA);
            PG8_WAIT_V(8); PG8_WAIT_L(0); PG8_BAR; PG8_MMA(0, 0, At, B0); PG8_MMA(0, 1, At, B1); PG8_BAR; PG8_SCHED;
            PG8_LDA(At, 0, 1); PG8_STAGE(PG8_SB(0, 0), b2, voffB); PG8_STAGE(PG8_SB(0, 1), b2 + hstep, voffB); PG8_STAGE(PG8_SA(0, 0), a2, voffA);
            PG8_WAIT_V(8); PG8_WAIT_L(0); PG8_BAR; PG8_MMA(1, 0, At, B0); PG8_MMA(1, 1, At, B1); PG8_BAR; PG8_SCHED;
            PG8_LDB(B0, 1, 0); PG8_LDB(B1, 1, 1); PG8_SCHED; PG8_LDA(At, 1, 0); PG8_STAGE(PG8_SA(0, 1), a2 + hstep, voffA);
            PG8_WAIT_V(8); PG8_WAIT_L(0); PG8_BAR; PG8_MMA(0, 0, At, B0); PG8_MMA(0, 1, At, B1); PG8_BAR; PG8_SCHED;
            PG8_LDA(At, 1, 1); PG8_STAGE(PG8_SB(1, 0), b3, voffB); PG8_STAGE(PG8_SB(1, 1), b3 + hstep, voffB); PG8_STAGE(PG8_SA(1, 0), a3, voffA);
            PG8_WAIT_V(8); PG8_WAIT_L(0); PG8_BAR; PG8_MMA(1, 0, At, B0); PG8_MMA(1, 1, At, B1); PG8_BAR; PG8_SCHED;
            } else {
            PG8_LDB(B0, 0, 0); PG8_SCHED; PG8_LDA(At, 0, 0); PG8_STAGE(PG8_SA(1, 1), a1 + hstep, voffA);
            PG8_WAIT_L(8); PG8_BAR; PG8_WAIT_L(0); PG8_MMA(0, 0, At, B0); PG8_BAR; PG8_SCHED;
            PG8_LDB(B1, 0, 1); PG8_STAGE(PG8_SB(0, 0), b2, voffB);
            PG8_BAR; PG8_WAIT_L(0); PG8_MMA(0, 1, At, B1); PG8_BAR;
            PG8_LDA(At, 0, 1); PG8_STAGE(PG8_SA(0, 0), a2, voffA);
            PG8_BAR; PG8_WAIT_L(0); PG8_MMA(1, 0, At, B0); PG8_BAR; PG8_SCHED;
            PG8_STAGE(PG8_SB(0, 1), b2 + hstep, voffB);
            PG8_WAIT_V(6); PG8_BAR; PG8_MMA(1, 1, At, B1); PG8_BAR;
            PG8_LDB(B0, 1, 0); PG8_SCHED; PG8_LDA(At, 1, 0); PG8_STAGE(PG8_SA(0, 1), a2 + hstep, voffA);
            PG8_WAIT_L(8); PG8_BAR; PG8_WAIT_L(0); PG8_MMA(0, 0, At, B0); PG8_BAR; PG8_SCHED;
            PG8_LDB(B1, 1, 1); PG8_STAGE(PG8_SB(1, 0), b3, voffB);
            PG8_BAR; PG8_WAIT_L(0); PG8_MMA(0, 1, At, B1); PG8_BAR;
            PG8_LDA(At, 1, 1); PG8_STAGE(PG8_SA(1, 0), a3, voffA);
            PG8_BAR; PG8_WAIT_L(0); PG8_MMA(1, 0, At, B0); PG8_BAR; PG8_SCHED;
            PG8_STAGE(PG8_SB(1, 1), b3 + hstep, voffB);
            PG8_WAIT_V(6); PG8_BAR; PG8_MMA(1, 1, At, B1); PG8_BAR;
            }
        }
        if constexpr (ALIGN_EPI) { if (wr == 0) PG8_BAR; }
        if constexpr (!Epi::AFTER_DRAIN) { E(acc, cur, wr, wc, fr, fq); S.done(cur); }
        if (!has_next) break;
#pragma unroll
        for (int a = 0; a < 2; ++a)
#pragma unroll
            for (int b = 0; b < 2; ++b)
#pragma unroll
                for (int m = 0; m < 4; ++m)
#pragma unroll
                    for (int n = 0; n < 2; ++n) acc[a][b][m][n] = (f32x4){0.f, 0.f, 0.f, 0.f};
        cur = nxt; cA = nA; cB = nB; ++ui;
        if constexpr (ALIGN_EPI) { if (wr == 1) PG8_BAR; }
    }
    PG8_WAIT_V(0);
    if constexpr (!ALIGN_EPI) { if (wr == 0) PG8_BAR; }
    PG8_BAR;
    if constexpr (Epi::AFTER_DRAIN) { E.fused(acc, cur, wr, wc, fr, fq, lds, wid, lane); S.done(cur); }
#undef PG8_SA
#undef PG8_SB
#undef PG8_STAGE
#undef PG8_LDA
#undef PG8_LDB
#undef PG8_MMA
#undef PG8_WAIT_V
#undef PG8_WAIT_L
#undef PG8_BAR
#undef PG8_SCHED
}
}
#define GAS __attribute__((address_space(1)))
#define LAS __attribute__((address_space(3)))
typedef unsigned short bf16;
typedef unsigned v4u __attribute__((ext_vector_type(4)));
typedef float f32x4 __attribute__((ext_vector_type(4)));
typedef short bf16x8 __attribute__((ext_vector_type(8)));
typedef GAS unsigned gu32;
typedef GAS unsigned long long gu64;
#define RLX_AGENT __ATOMIC_RELAXED, __HIP_MEMORY_SCOPE_AGENT
#define LDS_WAIT() asm volatile("s_waitcnt lgkmcnt(0)" ::: "memory")
#define VM_WAIT() asm volatile("s_waitcnt vmcnt(0)" ::: "memory")
__device__ __forceinline__ unsigned long long rt() { return __builtin_amdgcn_s_memrealtime(); }
__device__ __forceinline__ unsigned f2bf(float f) { unsigned u = __builtin_bit_cast(unsigned, f); return (u + 0x7fffu + ((u >> 16) & 1u)) >> 16; }
__device__ __forceinline__ unsigned pk2(float lo, float hi) { return f2bf(lo) | (f2bf(hi) << 16); }
#define XB_TMO      128
#define XB_XCNT(j)  (256  + 64 * (j))
#define XB_XSUB(j)  (1280 + 64 * (j))
#define XB_XGEN(j)  (2304 + 64 * (j))
#define XB_TOP      3328
#define XB_TOPGEN   3392
#define XCD_BAR_WORDS 3456
#define XB_SPIN_CAP (1u << 18)

__device__ __forceinline__ unsigned xb_ld(unsigned* p)              { return __hip_atomic_load(p, __ATOMIC_RELAXED, __HIP_MEMORY_SCOPE_AGENT); }
__device__ __forceinline__ unsigned xb_add(unsigned* p, unsigned v) { return __hip_atomic_fetch_add(p, v, __ATOMIC_RELAXED, __HIP_MEMORY_SCOPE_AGENT); }
__device__ __forceinline__ unsigned xb_xcc_id() { return (unsigned)__builtin_amdgcn_s_getreg((3 << 11) | 20) & 0xFu; }
#define XB_SPIN(cond, bar) do { unsigned _sp = 0; while (cond) { __builtin_amdgcn_s_sleep(1); \
    if ((++_sp & 255u) == 0u) { if (xb_ld(&(bar)[XB_TMO])) break; if (_sp > XB_SPIN_CAP) { atomicAdd(&(bar)[XB_TMO], 1u); break; } } } } while (0)

struct XcdBarrier {
    unsigned* bar; unsigned x;
    volatile LAS unsigned* st;
};

__device__ __forceinline__ XcdBarrier xcd_barrier_post(unsigned* bar, volatile LAS unsigned* st) {
    XcdBarrier b; b.bar = bar; b.x = xb_xcc_id(); b.st = st;
    if (threadIdx.x == 0) (void)xb_add(&bar[XB_XCNT(b.x)], 1u);
    return b;
}
__device__ __forceinline__ void xcd_barrier_complete(unsigned* bar, unsigned x, unsigned& nloc, unsigned& nx) {
    const unsigned G = gridDim.x * gridDim.y * gridDim.z;
    unsigned sum, cnt, mine, sp = 0u;
    for (;;) {
        sum = 0u; cnt = 0u; mine = 0u;
#pragma unroll
        for (unsigned j = 0; j < 16; ++j) { const unsigned c = xb_ld(&bar[XB_XCNT(j)]); sum += c; cnt += (c > 0u) ? 1u : 0u; mine = (j == x) ? c : mine; }
        if (sum == G) break;
        __builtin_amdgcn_s_sleep(1);
        if ((++sp & 255u) == 0u) { if (xb_ld(&bar[XB_TMO])) break; if (sp > XB_SPIN_CAP) { atomicAdd(&bar[XB_TMO], 1u); break; } }
    }
    nloc = mine > 0u ? mine : 1u; nx = cnt > 0u ? cnt : 1u;
}

__device__ __forceinline__ void xcd_barrier(const XcdBarrier& b) {
    asm volatile("s_waitcnt vmcnt(0)" ::: "memory");
    __syncthreads();
    if (threadIdx.x == 0) {
        unsigned* bar = b.bar; unsigned bx_ = b.x; asm volatile("" : "+s"(bar), "+s"(bx_));
        __builtin_amdgcn_s_waitcnt(0);
        unsigned nloc = b.st[0], nx = b.st[1];
        if (nloc == 0u) { xcd_barrier_complete(bar, bx_, nloc, nx); b.st[0] = nloc; b.st[1] = nx; }
        const unsigned old = xb_add(&bar[XB_XSUB(bx_)], 1u);
        const unsigned gen = old / nloc;
        if (old + 1u == (gen + 1u) * nloc) {
            __builtin_amdgcn_fence(__ATOMIC_RELEASE, "agent");
            asm volatile("s_waitcnt vmcnt(0)" ::: "memory");
            const unsigned og = xb_add(&bar[XB_TOP], 1u);
            const unsigned tg = og / nx;
            if (og + 1u == (tg + 1u) * nx) xb_add(&bar[XB_TOPGEN], 1u);
            else XB_SPIN(xb_ld(&bar[XB_TOPGEN]) == tg, bar);
            __builtin_amdgcn_fence(__ATOMIC_ACQUIRE, "agent");
            xb_add(&bar[XB_XGEN(bx_)], 1u);
            asm volatile("s_waitcnt vmcnt(0)" ::: "memory");
        } else {
            XB_SPIN(xb_ld(&bar[XB_XGEN(bx_)]) == gen, bar);
            __builtin_amdgcn_fence(__ATOMIC_ACQUIRE, "agent");
            asm volatile("s_waitcnt vmcnt(0)" ::: "memory");
        }
    }
    __syncthreads();
}

constexpr int DM = 2048, MT = 8192, NCTXR = 4096, DFF = 5632, NMOD = 6 * DM, MKV = 8704;
constexpr float LOG2E = 1.4426950408889634f, RMS_EPS = 1e-6f;
constexpr float WIN_SL2 = 0.125f * LOG2E, MLA_SL2 = 0.07216878364870322f * LOG2E;
constexpr size_t O_Y = 0, O_WK = 16777216, O_WV = 20971520, O_CKV = 25165824, O_KPE = 29360128;

constexpr size_t MiB = 1u << 20;
constexpr size_t A256(size_t x) { return (x + 255) & ~(size_t)255; }
constexpr size_t WS_CTL = 0, CTL_BYTES = 1 * MiB;
constexpr size_t WS_MODP = WS_CTL + CTL_BYTES;
constexpr size_t WS_MOD = WS_MODP + A256((size_t)4 * 8 * 3 * NMOD * 4);
constexpr size_t WS_ROPE = WS_MOD + A256((size_t)4 * 3 * NMOD * 4);
constexpr size_t WS_WQKV = WS_ROPE + A256(2048 * 4);
constexpr size_t WS_WOW = WS_WQKV + (size_t)2 * 3072 * 2048 * 2;
constexpr size_t WS_WIN = WS_WOW + (size_t)2 * 2048 * 2048 * 2;
constexpr size_t WS_WQB = WS_WIN + (size_t)2 * 1280 * 2048 * 2;
constexpr size_t WS_WKVB = WS_WQB + (size_t)2 * 3072 * 512 * 2;
constexpr size_t WS_WOM = WS_WKVB + (size_t)2 * 4096 * 512 * 2;
constexpr size_t WS_WGU = WS_WOM + (size_t)2 * 2048 * 2048 * 2;
constexpr size_t WS_WD = WS_WGU + (size_t)4 * 11264 * 2048 * 2;
constexpr size_t WS_X = WS_WD + (size_t)4 * 2048 * 5632 * 2;
constexpr size_t WS_H = WS_X + (size_t)MT * DM * 4;
constexpr size_t WS_Q = WS_H + (size_t)MT * DM * 2;
constexpr size_t WS_KB = WS_Q + (size_t)MT * 3072 * 2;
constexpr size_t WS_VB = WS_KB + (size_t)MT * 512 * 2;
constexpr size_t WS_CK = WS_VB + (size_t)MT * 512 * 2;
constexpr size_t WS_CV = WS_CK + (size_t)1024 * 512 * 2;
constexpr size_t WS_AO = WS_CV + (size_t)1024 * 512 * 2;
constexpr size_t WS_ACT = WS_AO + (size_t)MT * DM * 2;
constexpr size_t WS_RAW = WS_ACT + (size_t)MT * DFF * 2;
constexpr size_t WS_CQN = WS_RAW + (size_t)MT * 1280 * 4;
constexpr size_t WS_CKVN = WS_CQN + (size_t)MT * 512 * 2;
constexpr size_t WS_KPE = WS_CKVN + (size_t)MKV * 512 * 2;
constexpr size_t WS_KV = WS_KPE + (size_t)MKV * 64 * 2;
constexpr size_t WS_END = WS_KV + (size_t)MKV * 4096 * 2;
constexpr int CW_TMO = 0, CW_CODE = 1, CW_BAR = 4096;
constexpr int RING_BYTES = 131072, LDSCTL_OFF = RING_BYTES, MISC_OFF = LDSCTL_OFF + 320, LDS_BYTES = 147456;

__device__ __forceinline__ float wave_sum(float v) {
#pragma unroll
    for (int o = 1; o < 64; o <<= 1) v += __shfl_xor(v, o);
    return v;
}
__device__ __forceinline__ float wave_max(float v) {
#pragma unroll
    for (int o = 1; o < 64; o <<= 1) v = fmaxf(v, __shfl_xor(v, o));
    return v;
}
__device__ __forceinline__ float bf2f(unsigned short b) { return __builtin_bit_cast(float, ((unsigned)b) << 16); }
typedef unsigned v2u __attribute__((ext_vector_type(2)));
__device__ __forceinline__ v2u pk4(f32x4 v) { v2u r; r.x = pg8::cvt_pk_bf16(v[0], v[1]); r.y = pg8::cvt_pk_bf16(v[2], v[3]); return r; }

__device__ __forceinline__ int inv_perm32(int c) { return 16 * ((c >> 2) & 1) + 4 * (c >> 3) + (c & 3); }
__device__ __forceinline__ int dest_row(int kind, int n) {
    if (kind == 0) return n;
    return 256 * (n >> 7) + 32 * ((n & 127) >> 5) + inv_perm32(n & 31) + (kind == 2 ? 128 : 0);
}
__device__ __forceinline__ void p0_transpose_item(const float* W, int K, int N, bf16* WT, int kind, LAS float* scr, int item, int lane) {
    const int nblk = N / 32, kb = item / nblk, nb = item % nblk, k0 = 64 * kb, n0 = 32 * nb;
#pragma unroll 8
    for (int i = 0; i < 32; ++i) { const int kk = 2 * i + (lane >> 5); scr[kk * 33 + (lane & 31)] = W[(size_t)(k0 + kk) * N + n0 + (lane & 31)]; }
    LDS_WAIT(); asm volatile("" ::: "memory");
    const int c = lane & 7;
#pragma unroll
    for (int j = 0; j < 4; ++j) { const int n = (lane >> 3) + 8 * j; const LAS float* s = scr + (8 * c) * 33 + n;
        v4u o; o.x = pk2(s[0 * 33], s[1 * 33]); o.y = pk2(s[2 * 33], s[3 * 33]); o.z = pk2(s[4 * 33], s[5 * 33]); o.w = pk2(s[6 * 33], s[7 * 33]);
        *(GAS v4u*)(WT + (size_t)dest_row(kind, n0 + n) * K + k0 + 8 * c) = o; }
    LDS_WAIT(); asm volatile("" ::: "memory");
}
__device__ __forceinline__ void p0_gemv_item(const float* adaw, const float* c, const float* cctx, float* modp, LAS float* sl, int item, int lane) {
    const int ks = item & 7, cb = (item >> 3) % 48, l = item / 384;
    for (int i = lane; i < 768; i += 64) { const int cd = i >> 8, kk = i & 255; const float v = (cd == 0) ? cctx[256 * ks + kk] : c[(cd - 1) * 2048 + 256 * ks + kk]; sl[i] = v / (1.f + __expf(-v)); }
    LDS_WAIT(); asm volatile("" ::: "memory");
    const float* w = adaw + ((size_t)l * 2048 + 256 * ks) * NMOD + 256 * cb + 4 * lane;
    f32x4 a0 = {0.f, 0.f, 0.f, 0.f}, a1 = a0, a2 = a0;
#pragma unroll 8
    for (int r = 0; r < 256; ++r) { const f32x4 wv = *(const GAS f32x4*)(w + (size_t)r * NMOD); const float s0 = sl[r], s1 = sl[256 + r], s2 = sl[512 + r]; a0 += wv * s0; a1 += wv * s1; a2 += wv * s2; }
    float* o = modp + (((size_t)l * 8 + ks) * 3) * NMOD + 256 * cb + 4 * lane;
    *(GAS f32x4*)(o) = a0; *(GAS f32x4*)(o + NMOD) = a1; *(GAS f32x4*)(o + 2 * NMOD) = a2;
    LDS_WAIT(); asm volatile("" ::: "memory");
}
constexpr int GEMV_ITEMS = 4 * 48 * 8;
constexpr int TJ_ITEMS = 3072 + 2048 + 1088 + 768 + 1024 + 2048;
constexpr int TL_ITEMS = 3 * 5632;
constexpr int TR_ITEMS = 2 * TJ_ITEMS + 4 * TL_ITEMS;

__device__ __forceinline__ void norm_mod_phase(const float* xa, const float* xb, const float* gain, const float* mod_l, int sh_idx, int sc_idx, bf16* H, int gw, int NGW, int lane) {
    for (int m = gw; m < MT; m += NGW) {
        const float* xr = m < NCTXR ? xa + (size_t)m * DM : xb + (size_t)(m - NCTXR) * DM;
        const int cond = m < NCTXR ? 0 : (m < 6144 ? 1 : 2);
        const float* shv = mod_l + cond * NMOD + sh_idx * DM; const float* scv = mod_l + cond * NMOD + sc_idx * DM;
        f32x4 v[8]; float ss = 0.f;
#pragma unroll
        for (int j = 0; j < 8; ++j) { v[j] = ((const GAS f32x4*)xr)[lane + 64 * j]; ss += (v[j].x * v[j].x + v[j].y * v[j].y) + (v[j].z * v[j].z + v[j].w * v[j].w); }
        const float rstd = 1.f / sqrtf(wave_sum(ss) * (1.f / DM) + RMS_EPS);
#pragma unroll
        for (int j = 0; j < 8; ++j) { const f32x4 g = ((const GAS f32x4*)gain)[lane + 64 * j], sc = ((const GAS f32x4*)scv)[lane + 64 * j], sh = ((const GAS f32x4*)shv)[lane + 64 * j];
            const f32x4 y = (v[j] * rstd) * g * (sc + 1.f) + sh;
            *(GAS v2u*)(H + (size_t)m * DM + 4 * (lane + 64 * j)) = pk4(y); }
    }
}
__device__ __forceinline__ void final_norm_phase(const float* X, const float* gain, float* out, int gw, int NGW, int lane) {
    for (int m = gw; m < MT; m += NGW) {
        const float* xr = X + (size_t)m * DM; f32x4 v[8]; float ss = 0.f;
#pragma unroll
        for (int j = 0; j < 8; ++j) { v[j] = ((const GAS f32x4*)xr)[lane + 64 * j]; ss += (v[j].x * v[j].x + v[j].y * v[j].y) + (v[j].z * v[j].z + v[j].w * v[j].w); }
        const float rstd = 1.f / sqrtf(wave_sum(ss) * (1.f / DM) + RMS_EPS);
#pragma unroll
        for (int j = 0; j < 8; ++j) { const f32x4 g = ((const GAS f32x4*)gain)[lane + 64 * j]; ((GAS f32x4*)(out + (size_t)m * DM))[lane + 64 * j] = (v[j] * rstd) * g; }
    }
}
__device__ __forceinline__ void mla_norm_phase(const float* RAW, const float* qn, const float* kvn, const float* rope, const float* cache_ckv, const float* cache_kpe, int j,
                                               bf16* CQN, bf16* CKVN, bf16* KPE, float* out_ckv, float* out_kpe, int gw, int NGW, int lane) {
    for (int m = gw; m < MKV; m += NGW) {
        if (m < MT) {
            const float* r = RAW + (size_t)m * 1280;
            f32x4 q0 = ((const GAS f32x4*)r)[lane], q1 = ((const GAS f32x4*)r)[lane + 64];
            f32x4 k0 = ((const GAS f32x4*)(r + 512))[lane], k1 = ((const GAS f32x4*)(r + 512))[lane + 64];
            const float pe = r[1024 + lane];
            float sq = (q0.x * q0.x + q0.y * q0.y) + (q0.z * q0.z + q0.w * q0.w) + (q1.x * q1.x + q1.y * q1.y) + (q1.z * q1.z + q1.w * q1.w);
            float sk = (k0.x * k0.x + k0.y * k0.y) + (k0.z * k0.z + k0.w * k0.w) + (k1.x * k1.x + k1.y * k1.y) + (k1.z * k1.z + k1.w * k1.w);
            const float rq = 1.f / sqrtf(wave_sum(sq) * (1.f / 512.f) + RMS_EPS), rk = 1.f / sqrtf(wave_sum(sk) * (1.f / 512.f) + RMS_EPS);
            q0 = (q0 * rq) * ((const GAS f32x4*)qn)[lane]; q1 = (q1 * rq) * ((const GAS f32x4*)qn)[lane + 64];
            k0 = (k0 * rk) * ((const GAS f32x4*)kvn)[lane]; k1 = (k1 * rk) * ((const GAS f32x4*)kvn)[lane + 64];
            *(GAS v2u*)(CQN + (size_t)m * 512 + 4 * lane) = pk4(q0); *(GAS v2u*)(CQN + (size_t)m * 512 + 256 + 4 * lane) = pk4(q1);
            *(GAS v2u*)(CKVN + (size_t)m * 512 + 4 * lane) = pk4(k0); *(GAS v2u*)(CKVN + (size_t)m * 512 + 256 + 4 * lane) = pk4(k1);
            if (m < NCTXR) {
                const int b = m >> 8, s = m & 255; float* oc = out_ckv + ((size_t)(b * 2 + j) * 256 + s) * 512;
                ((GAS f32x4*)oc)[lane] = k0; ((GAS f32x4*)oc)[lane + 64] = k1;
                out_kpe[((size_t)(b * 2 + j) * 256 + s) * 64 + lane] = pe;
                KPE[(size_t)m * 64 + lane] = (bf16)f2bf(pe);
            } else {
                const int t = (m - NCTXR) & 2047; const int half = lane >> 5, i = lane & 15, part = (lane >> 4) & 1;
                const int pos = half ? (t & 63) : (t >> 6);
                const float cs = rope[pos * 16 + i], sn = rope[1024 + pos * 16 + i];
                const float other = __shfl_xor(pe, 16);
                const float o = part == 0 ? (pe * cs - other * sn) : (other * sn + pe * cs);
                KPE[(size_t)m * 64 + lane] = (bf16)f2bf(o);
            }
        } else {
            const int mm = m - MT, b = mm >> 8, s = mm & 255;
            const float* src = cache_ckv + ((size_t)(b * 2 + j) * 256 + s) * 512;
            const f32x4 k0 = ((const GAS f32x4*)src)[lane], k1 = ((const GAS f32x4*)src)[lane + 64];
            *(GAS v2u*)(CKVN + (size_t)m * 512 + 4 * lane) = pk4(k0); *(GAS v2u*)(CKVN + (size_t)m * 512 + 256 + 4 * lane) = pk4(k1);
            KPE[(size_t)m * 64 + lane] = (bf16)f2bf(cache_kpe[((size_t)(b * 2 + j) * 256 + s) * 64 + lane]);
        }
    }
}

using pg8::Unit;
struct EpiResid {
    static constexpr bool PERM = false, AFTER_DRAIN = false;
    const float* xa; const float* xb; float* xo; const float* mod_l; int gidx;
    __device__ __forceinline__ void operator()(const f32x4 (&acc)[2][2][4][2], const Unit& u, int wr, int wc, int fr, int fq) const {
        const int row0 = u.pm * 256 + wr * 64 + fr, col0 = u.pn * 256 + wc * 32 + 4 * fq;
        const int cond = u.pm < 16 ? 0 : (u.pm < 24 ? 1 : 2);
        const float* gv = mod_l + cond * NMOD + gidx * DM + col0;
        f32x4 g[2][2];
#pragma unroll
        for (int bj = 0; bj < 2; ++bj)
#pragma unroll
            for (int n = 0; n < 2; ++n) g[bj][n] = *(const GAS f32x4*)(gv + bj * 128 + n * 16);
#pragma unroll
        for (int ai = 0; ai < 2; ++ai)
#pragma unroll
            for (int m = 0; m < 4; ++m) { const int row = row0 + ai * 128 + m * 16;
                const float* xi = (u.pm < 16 ? xa + (size_t)row * DM : xb + (size_t)(row - NCTXR) * DM) + col0; float* xw = xo + (size_t)row * DM + col0;
#pragma unroll
                for (int bj = 0; bj < 2; ++bj)
#pragma unroll
                    for (int n = 0; n < 2; ++n) { const f32x4 x = *(const GAS f32x4*)(xi + bj * 128 + n * 16); *(GAS f32x4*)(xw + bj * 128 + n * 16) = x + g[bj][n] * acc[ai][bj][m][n]; }
                asm volatile("" ::: "memory"); }
    }
};
struct EpiSwiGLU {
    static constexpr bool PERM = false, AFTER_DRAIN = false;
    bf16* ACT;
    __device__ __forceinline__ void operator()(const f32x4 (&acc)[2][2][4][2], const Unit& u, int wr, int wc, int fr, int fq) const {
        const int row0 = u.pm * 256 + wr * 64 + fr, colb = u.pn * 128 + wc * 32 + 8 * fq;
#pragma unroll
        for (int ai = 0; ai < 2; ++ai)
#pragma unroll
            for (int m = 0; m < 4; ++m) { const int row = row0 + ai * 128 + m * 16; f32x4 a[2];
#pragma unroll
                for (int n = 0; n < 2; ++n) { const f32x4 gt = acc[ai][0][m][n], up = acc[ai][1][m][n];
#pragma unroll
                    for (int e = 0; e < 4; ++e) a[n][e] = gt[e] * __builtin_amdgcn_rcpf(1.f + __expf(-gt[e])) * up[e]; }
                v4u w; w.x = pg8::cvt_pk_bf16(a[0][0], a[0][1]); w.y = pg8::cvt_pk_bf16(a[0][2], a[0][3]); w.z = pg8::cvt_pk_bf16(a[1][0], a[1][1]); w.w = pg8::cvt_pk_bf16(a[1][2], a[1][3]);
                *(GAS v4u*)(ACT + (size_t)row * DFF + colb) = w; }
    }
};
struct EpiQkvWin {
    static constexpr bool PERM = false, AFTER_DRAIN = false;
    bf16* Q; bf16* Kb; bf16* Vb; float* outK; float* outV; const float* rope; int j;
    __device__ __forceinline__ void operator()(const f32x4 (&acc)[2][2][4][2], const Unit& u, int wr, int wc, int fr, int fq) const {
        const int row0 = u.pm * 256 + wr * 64 + fr, colt = u.pn * 256; const bool latent = u.pm >= 16;
        bf16* dst; int pitch, cbase; float* of = nullptr;
        if (colt < 2048) { dst = Q; pitch = 2048; cbase = colt; } else if (colt < 2560) { dst = Kb; pitch = 512; cbase = colt - 2048; of = outK; } else { dst = Vb; pitch = 512; cbase = colt - 2560; of = outV; }
        const bool dorope = latent && colt < 2560; const int c0 = cbase + wc * 32 + 4 * fq;
#pragma unroll
        for (int ai = 0; ai < 2; ++ai)
#pragma unroll
            for (int m = 0; m < 4; ++m) { const int row = row0 + ai * 128 + m * 16;
                f32x4 cs = {1.f, 1.f, 1.f, 1.f}, sn = {0.f, 0.f, 0.f, 0.f};
                if (dorope) { const int t = (row - NCTXR) & 2047; const int pos = (wc & 1) ? (t & 63) : (t >> 6); cs = *(const GAS f32x4*)(rope + pos * 16 + 4 * fq); sn = *(const GAS f32x4*)(rope + 1024 + pos * 16 + 4 * fq); }
#pragma unroll
                for (int bj = 0; bj < 2; ++bj) { const f32x4 x1 = acc[ai][bj][m][0], x2 = acc[ai][bj][m][1];
                    const f32x4 o1 = x1 * cs - x2 * sn, o2 = x1 * sn + x2 * cs;
                    bf16* d = dst + (size_t)row * pitch + c0 + bj * 128;
                    *(GAS v2u*)(d) = pk4(o1); *(GAS v2u*)(d + 16) = pk4(o2);
                    if (!latent && of) { const int b = row >> 8, s = row & 255; float* o = of + ((size_t)(b * 2 + j) * 256 + s) * 512 + c0 + bj * 128; *(GAS f32x4*)(o) = o1; *(GAS f32x4*)(o + 16) = o2; } }
            }
    }
};
struct EpiRawF32 {
    static constexpr bool PERM = false, AFTER_DRAIN = false;
    float* C; int ldc;
    __device__ __forceinline__ void operator()(const f32x4 (&acc)[2][2][4][2], const Unit& u, int wr, int wc, int fr, int fq) const {
        const int row0 = u.pm * 256 + wr * 64 + fr, col0 = u.pn * 256 + wc * 32 + 4 * fq;
#pragma unroll
        for (int ai = 0; ai < 2; ++ai)
#pragma unroll
            for (int m = 0; m < 4; ++m) { float* rowp = C + (size_t)(row0 + ai * 128 + m * 16) * ldc + col0;
#pragma unroll
                for (int bj = 0; bj < 2; ++bj)
#pragma unroll
                    for (int n = 0; n < 2; ++n) *(GAS f32x4*)(rowp + bj * 128 + n * 16) = acc[ai][bj][m][n]; }
    }
};
struct EpiQb {
    static constexpr bool PERM = false, AFTER_DRAIN = false;
    bf16* Qm; const float* rope;
    __device__ __forceinline__ void operator()(const f32x4 (&acc)[2][2][4][2], const Unit& u, int wr, int wc, int fr, int fq) const {
        const int row0 = u.pm * 256 + wr * 64 + fr, colt = u.pn * 256; const bool latent = u.pm >= 16;
        int rk[2];
#pragma unroll
        for (int bj = 0; bj < 2; ++bj) { const int gm = ((colt + bj * 128 + wc * 32) >> 5) % 6; rk[bj] = latent ? (gm == 4 ? 1 : (gm == 5 ? 2 : 0)) : 0; }
        const int c0 = colt + wc * 32 + 4 * fq;
#pragma unroll
        for (int ai = 0; ai < 2; ++ai)
#pragma unroll
            for (int m = 0; m < 4; ++m) { const int row = row0 + ai * 128 + m * 16; const int t = (row - NCTXR) & 2047;
#pragma unroll
                for (int bj = 0; bj < 2; ++bj) { f32x4 cs = {1.f, 1.f, 1.f, 1.f}, sn = {0.f, 0.f, 0.f, 0.f};
                    if (rk[bj]) { const int pos = rk[bj] == 2 ? (t & 63) : (t >> 6); cs = *(const GAS f32x4*)(rope + pos * 16 + 4 * fq); sn = *(const GAS f32x4*)(rope + 1024 + pos * 16 + 4 * fq); }
                    const f32x4 x1 = acc[ai][bj][m][0], x2 = acc[ai][bj][m][1];
                    const f32x4 o1 = x1 * cs - x2 * sn, o2 = x1 * sn + x2 * cs;
                    bf16* d = Qm + (size_t)row * 3072 + c0 + bj * 128;
                    *(GAS v2u*)(d) = pk4(o1); *(GAS v2u*)(d + 16) = pk4(o2); }
            }
    }
};
struct EpiBf16Plain {
    static constexpr bool PERM = false, AFTER_DRAIN = false;
    bf16* O; int ldc;
    __device__ __forceinline__ void operator()(const f32x4 (&acc)[2][2][4][2], const Unit& u, int wr, int wc, int fr, int fq) const {
        const int row0 = u.pm * 256 + wr * 64 + fr, col0 = u.pn * 256 + wc * 32 + 4 * fq;
#pragma unroll
        for (int ai = 0; ai < 2; ++ai)
#pragma unroll
            for (int m = 0; m < 4; ++m) { bf16* rowp = O + (size_t)(row0 + ai * 128 + m * 16) * ldc + col0;
#pragma unroll
                for (int bj = 0; bj < 2; ++bj)
#pragma unroll
                    for (int n = 0; n < 2; ++n) *(GAS v2u*)(rowp + bj * 128 + n * 16) = pk4(acc[ai][bj][m][n]); }
    }
};

struct KSeg { const bf16* k; const bf16* kr; const bf16* v; int ks, krs, vs, n, pos0; };
template <int DN, int DR, int DV>
__device__ __forceinline__ void attn_unit_naive(LAS float* sc, LAS float* qs, const bf16* qb, int qpitch, int tlog, bf16* ob, int opitch, int qpos0,
                                                const KSeg& s0, const KSeg& s1, int nseg, float sl2, const float* sink, int wave, int lane) {
    constexpr int DQ = DN + DR;
    for (int rr = 0; rr < 32; ++rr) {
        const int r = wave * 32 + rr, tt = r & ((1 << tlog) - 1), g = r >> tlog;
        const bf16* q = qb + (size_t)tt * qpitch + g * DQ;
        for (int d = lane; d < DQ; d += 64) qs[d] = bf2f(q[d]);
        LDS_WAIT(); asm volatile("" ::: "memory");
        float mx = sink ? sink[g] * LOG2E : -1e30f;
        int off = 0;
        for (int si = 0; si < nseg; ++si) { const KSeg& S = si ? s1 : s0;
            for (int k0 = 0; k0 < S.n; k0 += 64) { const int key = k0 + lane; float a = -INFINITY;
                if (key < S.n) { const bf16* kp = S.k + (size_t)key * S.ks; a = 0.f;
                    for (int d = 0; d < DN; d += 8) { const v4u kv = *(const v4u*)(kp + d); const unsigned w[4] = {kv.x, kv.y, kv.z, kv.w};
#pragma unroll
                        for (int e = 0; e < 4; ++e) { a += qs[d + 2 * e] * __builtin_bit_cast(float, w[e] << 16); a += qs[d + 2 * e + 1] * __builtin_bit_cast(float, w[e] & 0xffff0000u); } }
                    if (DR) { const bf16* rp = S.kr + (size_t)key * S.krs;
                        for (int d = 0; d < DR; d += 8) { const v4u kv = *(const v4u*)(rp + d); const unsigned w[4] = {kv.x, kv.y, kv.z, kv.w};
#pragma unroll
                            for (int e = 0; e < 4; ++e) { a += qs[DN + d + 2 * e] * __builtin_bit_cast(float, w[e] << 16); a += qs[DN + d + 2 * e + 1] * __builtin_bit_cast(float, w[e] & 0xffff0000u); } } }
                    a *= sl2;
                    if (S.pos0 >= 0) { const int dp = S.pos0 + key - (qpos0 + tt); if (dp > 128 || dp < -128) a = -INFINITY; }
                }
                sc[off + key] = a; mx = fmaxf(mx, a); }
            off += (S.n + 63) & ~63; }
        mx = wave_max(mx);
        LDS_WAIT(); asm volatile("" ::: "memory");
        float l = 0.f;
        for (int i = lane; i < off; i += 64) { const float pv = __builtin_amdgcn_exp2f(sc[i] - mx); sc[i] = pv; l += pv; }
        l = wave_sum(l) + (sink ? __builtin_amdgcn_exp2f(sink[g] * LOG2E - mx) : 0.f);
        LDS_WAIT(); asm volatile("" ::: "memory");
        float o[DV / 64];
#pragma unroll
        for (int e = 0; e < DV / 64; ++e) o[e] = 0.f;
        off = 0;
        for (int si = 0; si < nseg; ++si) { const KSeg& S = si ? s1 : s0;
            for (int key = 0; key < S.n; ++key) { const float pv = sc[off + key]; const bf16* vp = S.v + (size_t)key * S.vs;
#pragma unroll
                for (int e = 0; e < DV / 64; ++e) o[e] += pv * bf2f(vp[lane + 64 * e]); }
            off += (S.n + 63) & ~63; }
        const float inv = 1.f / l;
#pragma unroll
        for (int e = 0; e < DV / 64; ++e) ob[(size_t)tt * opitch + g * DV + lane + 64 * e] = (bf16)f2bf(o[e] * inv);
        LDS_WAIT(); asm volatile("" ::: "memory");
    }
}

#ifndef MK_PER_PHASE
#define MK_PER_PHASE 0
#endif
constexpr int NPHASES = 2 + 2 * (7 + 9) + 1;
struct Params { const float* in[25]; float* out; unsigned char* ws; int lo, hi; };
typedef pg8::StaticOrder SOrd;

#define CAS __attribute__((address_space(4)))
__device__ __forceinline__ const CAS char* kernarg_l() { const CAS char* ka = (const CAS char*)__builtin_amdgcn_kernarg_segment_ptr(); asm volatile("" : "+s"(ka)); return ka; }
__global__ void __launch_bounds__(512, 2) fwd_kernel(Params p) {
    extern __shared__ __attribute__((aligned(16))) unsigned char lds_raw[];
    LAS unsigned char* lds = (LAS unsigned char*)lds_raw;
    const int tid0 = threadIdx.x;
    const int G = gridDim.x;
    volatile LAS unsigned* MISC = (volatile LAS unsigned*)(lds + MISC_OFF);
    for (int u = tid0; u < (LDS_BYTES - LDSCTL_OFF) / 4; u += 512) ((LAS unsigned*)(lds + LDSCTL_OFF))[u] = 0u;
    __syncthreads();
    unsigned char* ws = p.ws; gu32* ctl = (gu32*)(ws + WS_CTL);
    const int lo = p.lo, hi = p.hi;
    XcdBarrier bar; bar.bar = (unsigned*)(ctl + CW_BAR); bar.x = 0; bar.st = MISC + 8;
    if (hi - lo > 1) bar = xcd_barrier_post((unsigned*)(ctl + CW_BAR), MISC + 8);

#define INP(k) (*(const float* const CAS*)(kernarg_l() + 8 * (k)))
#define WSP(T, OFF) ((T*)(wsl + (OFF)))
    float* out_ = p.out;
    int ph = 0;
#define PH_BEGIN { const bool run_ = (ph >= lo) && (ph < hi); if (run_) { unsigned char* wsl = ws; float* out = out_; int Gl = G, bx = (int)blockIdx.x, tidl = tid0; asm volatile("" : "+s"(wsl), "+s"(out), "+s"(Gl), "+s"(bx), "+v"(tidl)); const int tid = tidl, lane = tidl & 63, wave = __builtin_amdgcn_readfirstlane(tidl >> 6), gw = bx * 8 + wave, NGW = Gl * 8; (void)tid; (void)lane; (void)gw; (void)NGW;
#define PH_END } if (run_ && (ph + 1 < hi)) xcd_barrier(bar); ++ph; }

    PH_BEGIN
        LAS float* scr = (LAS float*)(lds + wave * 16384);
        for (int it = gw; it < GEMV_ITEMS + TR_ITEMS; it += NGW) {
            if (it < GEMV_ITEMS) { p0_gemv_item(INP(8), INP(6), INP(7), WSP(float, WS_MODP), scr, it, lane); continue; }
            int r = it - GEMV_ITEMS;
            if (r < 2 * TJ_ITEMS) { const int j = r / TJ_ITEMS; r -= j * TJ_ITEMS;
                if (r < 3072) { p0_transpose_item(INP(12) + (size_t)j * 2048 * 3072, 2048, 3072, WSP(bf16, WS_WQKV) + (size_t)j * 3072 * 2048, 0, scr, r, lane); continue; } r -= 3072;
                if (r < 2048) { p0_transpose_item(INP(13) + (size_t)j * 2048 * 2048, 2048, 2048, WSP(bf16, WS_WOW) + (size_t)j * 2048 * 2048, 0, scr, r, lane); continue; } r -= 2048;
                if (r < 1088) { p0_transpose_item(INP(15) + (size_t)j * 2048 * 1088, 2048, 1088, WSP(bf16, WS_WIN) + (size_t)j * 1280 * 2048, 0, scr, r, lane); continue; } r -= 1088;
                if (r < 768) { p0_transpose_item(INP(17) + (size_t)j * 512 * 3072, 512, 3072, WSP(bf16, WS_WQB) + (size_t)j * 3072 * 512, 0, scr, r, lane); continue; } r -= 768;
                if (r < 1024) { p0_transpose_item(INP(19) + (size_t)j * 512 * 4096, 512, 4096, WSP(bf16, WS_WKVB) + (size_t)j * 4096 * 512, 0, scr, r, lane); continue; } r -= 1024;
                p0_transpose_item(INP(20) + (size_t)j * 2048 * 2048, 2048, 2048, WSP(bf16, WS_WOM) + (size_t)j * 2048 * 2048, 0, scr, r, lane); continue; }
            r -= 2 * TJ_ITEMS; { const int l = r / TL_ITEMS; r -= l * TL_ITEMS;
                if (r < 5632) { p0_transpose_item(INP(21) + (size_t)l * 2048 * 5632, 2048, 5632, WSP(bf16, WS_WGU) + (size_t)l * 11264 * 2048, 1, scr, r, lane); continue; } r -= 5632;
                if (r < 5632) { p0_transpose_item(INP(22) + (size_t)l * 2048 * 5632, 2048, 5632, WSP(bf16, WS_WGU) + (size_t)l * 11264 * 2048, 2, scr, r, lane); continue; } r -= 5632;
                p0_transpose_item(INP(23) + (size_t)l * 5632 * 2048, 5632, 2048, WSP(bf16, WS_WD) + (size_t)l * 2048 * 5632, 0, scr, r, lane); }
        }
    PH_END
    PH_BEGIN
        const int gt = bx * 512 + tid, NT = Gl * 512;
        for (int idx = gt; idx < 4 * 3 * NMOD; idx += NT) { const int l = idx / (3 * NMOD), rem = idx - l * 3 * NMOD, cd = rem / NMOD, col = rem - cd * NMOD;
            float s = INP(9)[l * NMOD + col];
#pragma unroll
            for (int ks = 0; ks < 8; ++ks) s += WSP(float, WS_MODP)[(((size_t)l * 8 + ks) * 3 + cd) * NMOD + col];
            WSP(float, WS_MOD)[idx] = s; }
        for (int idx = gt; idx < 1024 * 512 / 4; idx += NT) { *(GAS v2u*)(WSP(bf16, WS_CK) + 4 * (size_t)idx) = pk4(((const GAS f32x4*)INP(2))[idx]); *(GAS v2u*)(WSP(bf16, WS_CV) + 4 * (size_t)idx) = pk4(((const GAS f32x4*)INP(3))[idx]); }
        if (bx == 0) for (int idx = tid; idx < 1024; idx += 512) { const int pos = idx >> 4, i = idx & 15; const float fr_ = powf(10000.f, -(float)i * (1.f / 16.f)); const float ang = (float)pos * fr_;
            WSP(float, WS_ROPE)[idx] = cosf(ang); WSP(float, WS_ROPE)[1024 + idx] = sinf(ang); }
    PH_END

    for (int layer = 0; layer < 4; ++layer) {
        const int j = layer >> 1; const bool is_win = !(layer & 1);
#define X_ WSP(float, WS_X)
#define XA_ (layer == 0 ? INP(0) : (const float*)X_)
#define XB_ (layer == 0 ? INP(1) : (const float*)(X_ + (size_t)NCTXR * DM))
#define MODL_ (WSP(float, WS_MOD) + (size_t)layer * 3 * NMOD)
        PH_BEGIN norm_mod_phase(XA_, XB_, INP(10) + layer * DM, MODL_, 0, 1, WSP(bf16, WS_H), gw, NGW, lane); PH_END
        if (is_win) {
            PH_BEGIN
                pg8::Gemm g{WSP(bf16, WS_H), WSP(bf16, WS_WQKV) + (size_t)j * 3072 * 2048, MT, 3072, DM}; SOrd S; S.init(MT, 3072, Gl, bx);
                EpiQkvWin E{WSP(bf16, WS_Q), WSP(bf16, WS_KB), WSP(bf16, WS_VB), out + O_WK, out + O_WV, WSP(float, WS_ROPE), j};
                pg8::gemm_phase<EpiQkvWin, SOrd, true, true>(lds, g, S, E);
            PH_END
            PH_BEGIN
                LAS float* sc = (LAS float*)(lds + wave * 9472); LAS float* qs = (LAS float*)(lds + 75776 + wave * 768);
                bf16* Q = WSP(bf16, WS_Q); bf16* Kb = WSP(bf16, WS_KB); bf16* Vb = WSP(bf16, WS_VB); bf16* CK = WSP(bf16, WS_CK); bf16* CV = WSP(bf16, WS_CV); bf16* AO = WSP(bf16, WS_AO);
                for (int u = bx; u < 1024; u += Gl) {
                    KSeg s0, s1; int nseg, qpos0 = 0; const bf16* qb; bf16* ob;
                    if (u < 512) { const int b = u >> 5, kvh = (u >> 2) & 7, tq = u & 3; const size_t row0 = (size_t)b * 256 + tq * 64;
                        qb = Q + row0 * 2048 + kvh * 256; ob = AO + row0 * 2048 + kvh * 256;
                        s0 = KSeg{Kb + (size_t)b * 256 * 512 + kvh * 64, nullptr, Vb + (size_t)b * 256 * 512 + kvh * 64, 512, 0, 512, 256, -1}; s1 = s0; nseg = 1;
                    } else { const int v = u - 512, b = v >> 8, kvh = (v >> 5) & 7, tq = v & 31; const size_t row0 = (size_t)NCTXR + b * 2048 + tq * 64;
                        qb = Q + row0 * 2048 + kvh * 256; ob = AO + row0 * 2048 + kvh * 256; qpos0 = tq * 64;
                        const size_t cb = (size_t)(b * 2 + j) * 256 * 512 + kvh * 64;
                        s0 = KSeg{CK + cb, nullptr, CV + cb, 512, 0, 512, 256, -1};
                        const int lo_k = max(0, tq * 64 - 128), hi_k = min(2048, tq * 64 + 192); const size_t kr = ((size_t)NCTXR + b * 2048 + lo_k) * 512 + kvh * 64;
                        s1 = KSeg{Kb + kr, nullptr, Vb + kr, 512, 0, 512, hi_k - lo_k, lo_k}; nseg = 2; }
                    attn_unit_naive<64, 0, 64>(sc, qs, qb, 2048, 6, ob, 2048, qpos0, s0, s1, nseg, WIN_SL2, INP(14) + j * 32 + ((u < 512 ? (u >> 2) : ((u - 512) >> 5)) & 7) * 4, wave, lane);
                }
            PH_END
        } else {
            PH_BEGIN
                pg8::Gemm g{WSP(bf16, WS_H), WSP(bf16, WS_WIN) + (size_t)j * 1280 * 2048, MT, 1280, DM}; SOrd S; S.init(MT, 1280, Gl, bx);
                EpiRawF32 E{WSP(float, WS_RAW), 1280};
                pg8::gemm_phase<EpiRawF32, SOrd, true, true>(lds, g, S, E);
            PH_END
            PH_BEGIN mla_norm_phase(WSP(float, WS_RAW), INP(16) + j * 512, INP(18) + j * 512, WSP(float, WS_ROPE), INP(4), INP(5), j, WSP(bf16, WS_CQN), WSP(bf16, WS_CKVN), WSP(bf16, WS_KPE), out + O_CKV, out + O_KPE, gw, NGW, lane); PH_END
            PH_BEGIN
                { pg8::Gemm g{WSP(bf16, WS_CQN), WSP(bf16, WS_WQB) + (size_t)j * 3072 * 512, MT, 3072, 512}; SOrd S; S.init(MT, 3072, Gl, bx);
                  EpiQb E{WSP(bf16, WS_Q), WSP(float, WS_ROPE)}; pg8::gemm_phase<EpiQb, SOrd, true, true>(lds, g, S, E); }
                { pg8::Gemm g{WSP(bf16, WS_CKVN), WSP(bf16, WS_WKVB) + (size_t)j * 4096 * 512, MKV, 4096, 512}; SOrd S; S.init(MKV, 4096, Gl, bx);
                  EpiBf16Plain E{WSP(bf16, WS_KV), 4096}; pg8::gemm_phase<EpiBf16Plain, SOrd, true, true>(lds, g, S, E); }
            PH_END
            PH_BEGIN
                LAS float* sc = (LAS float*)(lds + wave * 9472); LAS float* qs = (LAS float*)(lds + 75776 + wave * 768);
                bf16* Q = WSP(bf16, WS_Q); bf16* KV = WSP(bf16, WS_KV); bf16* KPE = WSP(bf16, WS_KPE); bf16* AO = WSP(bf16, WS_AO);
                for (int u = bx; u < 512; u += Gl) {
                    KSeg s0, s1; int nseg; const bf16* qb; bf16* ob;
                    if (u < 256) { const int b = u >> 4, h = u & 15; const size_t row0 = (size_t)b * 256;
                        qb = Q + row0 * 3072 + h * 192; ob = AO + row0 * 2048 + h * 128;
                        s0 = KSeg{KV + row0 * 4096 + h * 256, KPE + row0 * 64, KV + row0 * 4096 + h * 256 + 128, 4096, 64, 4096, 256, -1}; s1 = s0; nseg = 1;
                    } else { const int v = u - 256, b = v >> 7, h = (v >> 3) & 15, tq = v & 7; const size_t row0 = (size_t)NCTXR + b * 2048 + tq * 256;
                        qb = Q + row0 * 3072 + h * 192; ob = AO + row0 * 2048 + h * 128;
                        const size_t kr0 = (size_t)NCTXR + b * 2048, cr0 = (size_t)MT + b * 256;
                        s0 = KSeg{KV + kr0 * 4096 + h * 256, KPE + kr0 * 64, KV + kr0 * 4096 + h * 256 + 128, 4096, 64, 4096, 2048, -1};
                        s1 = KSeg{KV + cr0 * 4096 + h * 256, KPE + cr0 * 64, KV + cr0 * 4096 + h * 256 + 128, 4096, 64, 4096, 256, -1}; nseg = 2; }
                    attn_unit_naive<128, 64, 128>(sc, qs, qb, 3072, 8, ob, 2048, 0, s0, s1, nseg, MLA_SL2, nullptr, wave, lane);
                }
            PH_END
        }
        PH_BEGIN
            pg8::Gemm g{WSP(bf16, WS_AO), (is_win ? WSP(bf16, WS_WOW) : WSP(bf16, WS_WOM)) + (size_t)j * 2048 * 2048, MT, DM, DM}; SOrd S; S.init(MT, DM, Gl, bx);
            EpiResid E{XA_, XB_, X_, MODL_, 2};
            pg8::gemm_phase<EpiResid, SOrd, true, true>(lds, g, S, E);
        PH_END
        PH_BEGIN norm_mod_phase(X_, X_ + (size_t)NCTXR * DM, INP(11) + layer * DM, MODL_, 3, 4, WSP(bf16, WS_H), gw, NGW, lane); PH_END
        PH_BEGIN
            pg8::Gemm g{WSP(bf16, WS_H), WSP(bf16, WS_WGU) + (size_t)layer * 11264 * 2048, MT, 11264, DM}; SOrd S; S.init(MT, 11264, Gl, bx);
            EpiSwiGLU E{WSP(bf16, WS_ACT)};
            pg8::gemm_phase<EpiSwiGLU, SOrd, true, true>(lds, g, S, E);
        PH_END
        PH_BEGIN
            pg8::Gemm g{WSP(bf16, WS_ACT), WSP(bf16, WS_WD) + (size_t)layer * 2048 * 5632, MT, DM, DFF}; SOrd S; S.init(MT, DM, Gl, bx);
            EpiResid E{X_, X_ + (size_t)NCTXR * DM, X_, MODL_, 5};
            pg8::gemm_phase<EpiResid, SOrd, true, true>(lds, g, S, E);
        PH_END
    }
    PH_BEGIN final_norm_phase(WSP(float, WS_X), INP(24), out + O_Y, gw, NGW, lane); PH_END
#undef PH_BEGIN
#undef PH_END
}

extern "C" void kernel_launch(void* const* d_in, const int* in_sizes, int n_in, void* d_out, int out_size, void* d_ws, size_t ws_size, hipStream_t stream) {
    static int grid = 0;
    if (grid == 0) {
        if (n_in != 25 || ws_size < WS_END) { fprintf(stderr, "kernel_launch: expected 25 inputs and >= %zu bytes of workspace; got %d, %zu\n", (size_t)WS_END, n_in, ws_size); grid = -1; return; }
        int dev = 0, cus = 0, per_cu = 0;
        if (hipGetDevice(&dev) != hipSuccess || hipDeviceGetAttribute(&cus, hipDeviceAttributeMultiprocessorCount, dev) != hipSuccess) { grid = -1; return; }
        if (hipFuncSetAttribute((const void*)fwd_kernel, hipFuncAttributeMaxDynamicSharedMemorySize, LDS_BYTES) != hipSuccess) { fprintf(stderr, "kernel_launch: hipFuncSetAttribute failed\n"); grid = -1; return; }
        if (hipOccupancyMaxActiveBlocksPerMultiprocessor(&per_cu, (const void*)fwd_kernel, 512, LDS_BYTES) != hipSuccess || per_cu < 1) { fprintf(stderr, "kernel_launch: occupancy query reports %d blocks per CU\n", per_cu); }
        (void)hipGetLastError();
        grid = cus;
    }
    if (grid < 0) return;
    (void)hipMemsetAsync((char*)d_ws + WS_CTL, 0, CTL_BYTES, stream);
    Params a{};
    for (int i = 0; i < 25; ++i) a.in[i] = (const float*)d_in[i];
    a.out = (float*)d_out; a.ws = (unsigned char*)d_ws;
#if MK_PER_PHASE
    for (int ph = 0; ph < NPHASES; ++ph) { a.lo = ph; a.hi = ph + 1; hipLaunchKernelGGL(fwd_kernel, dim3(grid), dim3(512), LDS_BYTES, stream, a); }
#else
    a.lo = 0; a.hi = NPHASES; hipLaunchKernelGGL(fwd_kernel, dim3(grid), dim3(512), LDS_BYTES, stream, a);
#endif
}
```

```cpp
#include <hip/hip_runtime.h>
#include <cstdio>
#include <cstdint>
namespace pg8 {
#define PG8_LAS __attribute__((address_space(3)))
typedef unsigned short bf16_t;
typedef short bf16x8 __attribute__((ext_vector_type(8)));
typedef float f32x4 __attribute__((ext_vector_type(4)));
typedef unsigned u32x4 __attribute__((ext_vector_type(4)));
constexpr int BM = 256, BK = 64, HALF = 128, HTB = HALF * BK * 2  , STAGE_BYTES = 8 * HTB, NXCD = 8, WGM = 8;

__host__ __device__ __forceinline__ int lds_byte(int r, int c) { const int st = (r >> 4) * 2 + (c >> 5), rr = r & 15, cc = c & 31, ob = rr * 64 + cc * 2; return st * 1024 + (ob ^ (((ob >> 9) & 1) << 5)); }
__host__ __device__ __forceinline__ void stage_rc(int b, int& R, int& C) { const int st = b / 1024, sb = b % 1024, swz = sb ^ (((sb >> 9) & 1) << 5); R = (st >> 1) * 16 + swz / 64; C = (st & 1) * 32 + (swz % 64) / 2; }
__host__ __device__ __forceinline__ int perm32(int rho) { const int n = rho >> 4, i = rho & 15; return 8 * (i >> 2) + 4 * n + (i & 3); }

struct Unit { int pm, pn; };
struct Gemm { const bf16_t* A; const bf16_t* Bt; int M, N, K; };

struct StaticOrder {
    int nM, nN, nwg, G, c;
    __host__ __device__ void init(int M, int N, int G_, int c_) { nM = M / BM; nN = N / BM; nwg = nM * nN; G = G_; c = c_; }
    __host__ __device__ bool next(int i, Unit& u) const {
        const long L = (long)i * G + c; if (L >= nwg) return false;
        int wgid = (int)L; { const int q = nwg / NXCD, r = nwg % NXCD, xcd = wgid % NXCD, off = wgid / NXCD; wgid = (xcd < r ? xcd * (q + 1) : r * (q + 1) + (xcd - r) * q) + off; }
        const int nig = WGM * nN, gid = wgid / nig, fm = gid * WGM, gsz = (nM - fm) < WGM ? (nM - fm) : WGM;
        u.pm = fm + ((wgid % nig) % gsz); u.pn = (wgid % nig) / gsz; return true;
    }
    __device__ __forceinline__ void a_ready(const Unit&) const {}
    __device__ __forceinline__ void done(const Unit&) const {}
};

__device__ __forceinline__ unsigned cvt_pk_bf16(float lo, float hi) { unsigned r; asm volatile("v_cvt_pk_bf16_f32 %0, %1, %2" : "=v"(r) : "v"(lo), "v"(hi)); return r; }
typedef float f32x2 __attribute__((ext_vector_type(2)));
template <class Epi, class Sched, bool ALIGN_EPI = false, bool SP2 = false>
__device__ __forceinline__ void gemm_phase(PG8_LAS unsigned char* lds, const Gemm g, const Sched& S, const Epi& E, const int tid_in) {
    int tid_ = tid_in; asm volatile("" : "+v"(tid_));
    const int tid = tid_, wid = __builtin_amdgcn_readfirstlane(tid >> 6), lane = tid & 63, wr = wid >> 2, wc = wid & 3, fr = lane & 15, fq = lane >> 4;
    const int K = g.K, nt = K / BK;
    unsigned voffA[2], voffB[2];
#pragma unroll
    for (int i = 0; i < 2; ++i) { int R, C; stage_rc(tid * 16 + i * 8192, R, C); const int Rb = Epi::PERM ? ((R & ~31) + perm32(R & 31)) : R;
        voffA[i] = (unsigned)(R * K + C) * 2u; voffB[i] = (unsigned)(Rb * K + C) * 2u; }
    const size_t kstep = (size_t)(BK * 2);
    const size_t hstep = (size_t)HALF * K * 2;
    const size_t tstep = 2 * hstep;
    const unsigned ldsw = (unsigned)wid * 1024u;
    const int aoff = lds_byte(wr * 64 + fr, fq * 8), boff = lds_byte(wc * 32 + fr, fq * 8);
#define PG8_SA(b, h) (((b) * 2 + (h)) * HTB)
#define PG8_SB(b, h) ((4 + (b) * 2 + (h)) * HTB)
#define PG8_STAGE(bufoff, gbase, voff) do { _Pragma("unroll") for (int _i = 0; _i < 2; ++_i) \
        __builtin_amdgcn_global_load_lds((const unsigned*)((const char*)(gbase) + (voff)[_i]), (PG8_LAS unsigned*)(lds + (bufoff) + ldsw + _i * 8192), 16, 0, 0); } while (0)
#define PG8_LDA(dst, b, h) do { _Pragma("unroll") for (int m = 0; m < 4; ++m) _Pragma("unroll") for (int k = 0; k < 2; ++k) dst[m][k] = *(const PG8_LAS bf16x8*)(lds + PG8_SA(b, h) + aoff + m * 2048 + k * 1024); } while (0)
#define PG8_LDB(dst, b, h) do { _Pragma("unroll") for (int n = 0; n < 2; ++n) _Pragma("unroll") for (int k = 0; k < 2; ++k) dst[n][k] = *(const PG8_LAS bf16x8*)(lds + PG8_SB(b, h) + boff + n * 2048 + k * 1024); } while (0)
#define PG8_MMA(ai, bj, At, Bt) do { __builtin_amdgcn_s_setprio(1); _Pragma("unroll") for (int m = 0; m < 4; ++m) _Pragma("unroll") for (int n = 0; n < 2; ++n) _Pragma("unroll") for (int k = 0; k < 2; ++k) \
        acc[ai][bj][m][n] = __builtin_amdgcn_mfma_f32_16x16x32_bf16(Bt[n][k], At[m][k], acc[ai][bj][m][n], 0, 0, 0); __builtin_amdgcn_s_setprio(0); } while (0)
#define PG8_WAIT_V(n) asm volatile("s_waitcnt vmcnt(" #n ")" ::: "memory")
#define PG8_WAIT_L(n) asm volatile("s_waitcnt lgkmcnt(" #n ")" ::: "memory")
#define PG8_BAR __builtin_amdgcn_s_barrier()
#define PG8_SCHED __builtin_amdgcn_sched_barrier(0)
    Unit cur, nxt; int ui = 0;
    if (!S.next(0, cur)) return;
    f32x4 acc[2][2][4][2];
#pragma unroll
    for (int a = 0; a < 2; ++a)
#pragma unroll
        for (int b = 0; b < 2; ++b)
#pragma unroll
            for (int m = 0; m < 4; ++m)
#pragma unroll
                for (int n = 0; n < 2; ++n) acc[a][b][m][n] = (f32x4){0.f, 0.f, 0.f, 0.f};
    bf16x8 At[4][2], B0[2][2], B1[2][2];
    const char* cA = (const char*)g.A + (size_t)cur.pm * tstep; const char* cB = (const char*)g.Bt + (size_t)cur.pn * tstep;
    S.a_ready(cur);
    if constexpr (SP2) {
        PG8_STAGE(PG8_SB(0, 0), cB, voffB); PG8_STAGE(PG8_SB(0, 1), cB + hstep, voffB); PG8_STAGE(PG8_SA(0, 0), cA, voffA); PG8_STAGE(PG8_SA(0, 1), cA + hstep, voffA);
        if (wr == 1) PG8_BAR;
        PG8_WAIT_V(2); PG8_BAR;
        PG8_STAGE(PG8_SB(1, 0), cB + kstep, voffB); PG8_STAGE(PG8_SA(1, 0), cA + kstep, voffA); PG8_STAGE(PG8_SB(1, 1), cB + hstep + kstep, voffB);
        PG8_WAIT_V(6); PG8_BAR;
    } else {
        PG8_STAGE(PG8_SB(0, 0), cB, voffB); PG8_STAGE(PG8_SA(0, 0), cA, voffA); PG8_STAGE(PG8_SB(0, 1), cB + hstep, voffB); PG8_STAGE(PG8_SA(0, 1), cA + hstep, voffA);
        if (wr == 1) PG8_BAR;
        PG8_WAIT_V(4); PG8_BAR;
        PG8_STAGE(PG8_SB(1, 0), cB + kstep, voffB); PG8_STAGE(PG8_SA(1, 0), cA + kstep, voffA); PG8_STAGE(PG8_SB(1, 1), cB + hstep + kstep, voffB);
        PG8_WAIT_V(6); PG8_BAR;
    }
    for (;;) {
        const bool has_next = S.next(ui + 1, nxt);
        const char* nA = has_next ? (const char*)g.A + (size_t)nxt.pm * tstep : cA; const char* nB = has_next ? (const char*)g.Bt + (size_t)nxt.pn * tstep : cB;
        for (int t = 0; t < nt; t += 2) {
            const bool last = (t == nt - 2);
            const char* a1 = cA + (size_t)(t + 1) * kstep;
            const char* a2 = last ? nA : cA + (size_t)(t + 2) * kstep; const char* b2 = last ? nB : cB + (size_t)(t + 2) * kstep;
            const char* a3 = a2 + kstep; const char* b3 = b2 + kstep;
            if (last && has_next) S.a_ready(nxt);
            if constexpr (SP2) {
            PG8_LDB(B0, 0, 0); PG8_LDB(B1, 0, 1); PG8_SCHED; PG8_LDA(At, 0, 0); PG8_STAGE(PG8_SA(1, 1), a1 + hstep, voffA);
            PG8_WAIT_V(8); PG8_WAIT_L(0); PG8_BAR; PG8_MMA(0, 0, At, B0); PG8_MMA(0, 1, At, B1); PG8_BAR; PG8_SCHED;
            PG8_LDA(At, 0, 1); PG8_STAGE(PG8_SB(0, 0), b2, voffB); PG8_STAGE(PG8_SB(0, 1), b2 + hstep, voffB); PG8_STAGE(PG8_SA(0, 0), a2, voffA);
            PG8_WAIT_V(8); PG8_WAIT_L(0); PG8_BAR; PG8_MMA(1, 0, At, B0); PG8_MMA(1, 1, At, B1); PG8_BAR; PG8_SCHED;
            PG8_LDB(B0, 1, 0); PG8_LDB(B1, 1, 1); PG8_SCHED; PG8_LDA(At, 1, 0); PG8_STAGE(PG8_SA(0, 1), a2 + hstep, voffA);
            PG8_WAIT_V(8); PG8_WAIT_L(0); PG8_BAR; PG8_MMA(0, 0, At, B0); PG8_MMA(0, 1, At, B1); PG8_BAR; PG8_SCHED;
            PG8_LDA(At, 1, 1); PG8_STAGE(PG8_SB(1, 0), b3, voffB); PG8_STAGE(PG8_SB(1, 1), b3 + hstep, voffB); PG8_STAGE(PG8_SA(1, 0), a3, voffA);
            PG8_WAIT_V(8); PG8_WAIT_L(0); PG8_BAR; PG8_MMA(1, 0, At, B0); PG8_MMA(1, 1, At, B1); PG8_BAR; PG8_SCHED;
            } else {
            PG8_LDB(B0, 0, 0); PG8_SCHED; PG8_LDA(At, 0, 0); PG8_STAGE(PG8_SA(1, 1), a1 + hstep, voffA);
            PG8_WAIT_L(8); PG8_BAR; PG8_WAIT_L(0); PG8_MMA(0, 0, At, B0); PG8_BAR; PG8_SCHED;
            PG8_LDB(B1, 0, 1); PG8_STAGE(PG8_SB(0, 0), b2, voffB);
            PG8_BAR; PG8_WAIT_L(0); PG8_MMA(0, 1, At, B1); PG8_BAR;
            PG8_LDA(At, 0, 1); PG8_STAGE(PG8_SA(0, 0), a2, voffA);
            PG8_BAR; PG8_WAIT_L(0); PG8_MMA(1, 0, At, B0); PG8_BAR; PG8_SCHED;
            PG8_STAGE(PG8_SB(0, 1), b2 + hstep, voffB);
            PG8_WAIT_V(6); PG8_BAR; PG8_MMA(1, 1, At, B1); PG8_BAR;
            PG8_LDB(B0, 1, 0); PG8_SCHED; PG8_LDA(At, 1, 0); PG8_STAGE(PG8_SA(0, 1), a2 + hstep, voffA);
            PG8_WAIT_L(8); PG8_BAR; PG8_WAIT_L(0); PG8_MMA(0, 0, At, B0); PG8_BAR; PG8_SCHED;
            PG8_LDB(B1, 1, 1); PG8_STAGE(PG8_SB(1, 0), b3, voffB);
            PG8_BAR; PG8_WAIT_L(0); PG8_MMA(0, 1, At, B1); PG8_BAR;
            PG8_LDA(At, 1, 1); PG8_STAGE(PG8_SA(1, 0), a3, voffA);
            PG8_BAR; PG8_WAIT_L(0); PG8_MMA(1, 0, At, B0); PG8_BAR; PG8_SCHED;
            PG8_STAGE(PG8_SB(1, 1), b3 + hstep, voffB);
            PG8_WAIT_V(6); PG8_BAR; PG8_MMA(1, 1, At, B1); PG8_BAR;
            }
        }
        if constexpr (ALIGN_EPI) { if (wr == 0) PG8_BAR; }
        if constexpr (!Epi::AFTER_DRAIN) { E(acc, cur, wr, wc, fr, fq); S.done(cur); }
        if (!has_next) break;
#pragma unroll
        for (int a = 0; a < 2; ++a)
#pragma unroll
            for (int b = 0; b < 2; ++b)
#pragma unroll
                for (int m = 0; m < 4; ++m)
#pragma unroll
                    for (int n = 0; n < 2; ++n) acc[a][b][m][n] = (f32x4){0.f, 0.f, 0.f, 0.f};
        cur = nxt; cA = nA; cB = nB; ++ui;
        if constexpr (ALIGN_EPI) { if (wr == 1) PG8_BAR; }
    }
    PG8_WAIT_V(0);
    if constexpr (!ALIGN_EPI) { if (wr == 0) PG8_BAR; }
    PG8_BAR;
    if constexpr (Epi::AFTER_DRAIN) { E.fused(acc, cur, wr, wc, fr, fq, lds, wid, lane); S.done(cur); }
#undef PG8_SA
#undef PG8_SB
#undef PG8_STAGE
#undef PG8_LDA
#undef PG8_LDB
#undef PG8_MMA
#undef PG8_WAIT_V
#undef PG8_WAIT_L
#undef PG8_BAR
#undef PG8_SCHED
}
}
#define GAS __attribute__((address_space(1)))
#define LAS __attribute__((address_space(3)))
typedef unsigned short bf16;
typedef unsigned v4u __attribute__((ext_vector_type(4)));
typedef float f32x4 __attribute__((ext_vector_type(4)));
typedef short bf16x8 __attribute__((ext_vector_type(8)));
typedef GAS unsigned gu32;
typedef GAS unsigned long long gu64;
#define RLX_AGENT __ATOMIC_RELAXED, __HIP_MEMORY_SCOPE_AGENT
#define LDS_WAIT() asm volatile("s_waitcnt lgkmcnt(0)" ::: "memory")
#define VM_WAIT() asm volatile("s_waitcnt vmcnt(0)" ::: "memory")
__device__ __forceinline__ unsigned long long rt() { return __builtin_amdgcn_s_memrealtime(); }
__device__ __forceinline__ unsigned f2bf(float f) { unsigned u = __builtin_bit_cast(unsigned, f); return (u + 0x7fffu + ((u >> 16) & 1u)) >> 16; }
__device__ __forceinline__ unsigned pk2(float lo, float hi) { return f2bf(lo) | (f2bf(hi) << 16); }
#define XB_TMO      128
#define XB_XCNT(j)  (256  + 64 * (j))
#define XB_XSUB(j)  (1280 + 64 * (j))
#define XB_XGEN(j)  (2304 + 64 * (j))
#define XB_TOP      3328
#define XB_TOPGEN   3392
#define XCD_BAR_WORDS 3456
#define XB_SPIN_CAP (1u << 18)

__device__ __forceinline__ unsigned xb_ld(unsigned* p)              { return __hip_atomic_load(p, __ATOMIC_RELAXED, __HIP_MEMORY_SCOPE_AGENT); }
__device__ __forceinline__ unsigned xb_add(unsigned* p, unsigned v) { return __hip_atomic_fetch_add(p, v, __ATOMIC_RELAXED, __HIP_MEMORY_SCOPE_AGENT); }
__device__ __forceinline__ unsigned xb_xcc_id() { return (unsigned)__builtin_amdgcn_s_getreg((3 << 11) | 20) & 0xFu; }
#define XB_SPIN(cond, bar) do { unsigned _sp = 0; while (cond) { __builtin_amdgcn_s_sleep(1); \
    if ((++_sp & 255u) == 0u) { if (xb_ld(&(bar)[XB_TMO])) break; if (_sp > XB_SPIN_CAP) { atomicAdd(&(bar)[XB_TMO], 1u); break; } } } } while (0)

struct XcdBarrier {
    unsigned* bar; unsigned x;
    volatile LAS unsigned* st;
};

__device__ __forceinline__ XcdBarrier xcd_barrier_post(unsigned* bar, volatile LAS unsigned* st) {
    XcdBarrier b; b.bar = bar; b.x = xb_xcc_id(); b.st = st;
    if (threadIdx.x == 0) (void)xb_add(&bar[XB_XCNT(b.x)], 1u);
    return b;
}
__device__ __forceinline__ void xcd_barrier_complete(unsigned* bar, unsigned x, unsigned& nloc, unsigned& nx) {
    const unsigned G = gridDim.x * gridDim.y * gridDim.z;
    unsigned sum, cnt, mine, sp = 0u;
    for (;;) {
        sum = 0u; cnt = 0u; mine = 0u;
#pragma unroll
        for (unsigned j = 0; j < 16; ++j) { const unsigned c = xb_ld(&bar[XB_XCNT(j)]); sum += c; cnt += (c > 0u) ? 1u : 0u; mine = (j == x) ? c : mine; }
        if (sum == G) break;
        __builtin_amdgcn_s_sleep(1);
        if ((++sp & 255u) == 0u) { if (xb_ld(&bar[XB_TMO])) break; if (sp > XB_SPIN_CAP) { atomicAdd(&bar[XB_TMO], 1u); break; } }
    }
    nloc = mine > 0u ? mine : 1u; nx = cnt > 0u ? cnt : 1u;
}

__device__ __forceinline__ void xcd_barrier(const XcdBarrier& b) {
    asm volatile("s_waitcnt vmcnt(0)" ::: "memory");
    __syncthreads();
    if (threadIdx.x == 0) {
        unsigned* bar = b.bar; unsigned bx_ = b.x; asm volatile("" : "+s"(bar), "+s"(bx_));
        __builtin_amdgcn_s_waitcnt(0);
        unsigned nloc = b.st[0], nx = b.st[1];
        if (nloc == 0u) { xcd_barrier_complete(bar, bx_, nloc, nx); b.st[0] = nloc; b.st[1] = nx; }
        const unsigned old = xb_add(&bar[XB_XSUB(bx_)], 1u);
        const unsigned gen = old / nloc;
        if (old + 1u == (gen + 1u) * nloc) {
            __builtin_amdgcn_fence(__ATOMIC_RELEASE, "agent");
            asm volatile("s_waitcnt vmcnt(0)" ::: "memory");
            const unsigned og = xb_add(&bar[XB_TOP], 1u);
            const unsigned tg = og / nx;
            if (og + 1u == (tg + 1u) * nx) xb_add(&bar[XB_TOPGEN], 1u);
            else XB_SPIN(xb_ld(&bar[XB_TOPGEN]) == tg, bar);
            __builtin_amdgcn_fence(__ATOMIC_ACQUIRE, "agent");
            xb_add(&bar[XB_XGEN(bx_)], 1u);
            asm volatile("s_waitcnt vmcnt(0)" ::: "memory");
        } else {
            XB_SPIN(xb_ld(&bar[XB_XGEN(bx_)]) == gen, bar);
            __builtin_amdgcn_fence(__ATOMIC_ACQUIRE, "agent");
            asm volatile("s_waitcnt vmcnt(0)" ::: "memory");
        }
    }
    __syncthreads();
}

constexpr int DM = 2048, MT = 8192, NCTXR = 4096, DFF = 5632, NMOD = 6 * DM, MKV = 8704;
constexpr float LOG2E = 1.4426950408889634f, RMS_EPS = 1e-6f;
constexpr float WIN_SL2 = 0.125f * LOG2E, MLA_SL2 = 0.07216878364870322f * LOG2E;
constexpr size_t O_Y = 0, O_WK = 16777216, O_WV = 20971520, O_CKV = 25165824, O_KPE = 29360128;

constexpr size_t MiB = 1u << 20;
constexpr size_t A256(size_t x) { return (x + 255) & ~(size_t)255; }
constexpr size_t WS_CTL = 0, CTL_BYTES = 1 * MiB;
constexpr size_t WS_MODP = WS_CTL + CTL_BYTES;
constexpr size_t WS_MOD = WS_MODP + A256((size_t)4 * 8 * 3 * NMOD * 4);
constexpr size_t WS_ROPE = WS_MOD + A256((size_t)4 * 3 * NMOD * 4);
constexpr size_t WS_WQKV = WS_ROPE + A256(2048 * 4);
constexpr size_t WS_WOW = WS_WQKV + (size_t)2 * 3072 * 2048 * 2;
constexpr size_t WS_WIN = WS_WOW + (size_t)2 * 2048 * 2048 * 2;
constexpr size_t WS_WQB = WS_WIN + (size_t)2 * 1280 * 2048 * 2;
constexpr size_t WS_WKVB = WS_WQB + (size_t)2 * 3072 * 512 * 2;
constexpr size_t WS_WOM = WS_WKVB + (size_t)2 * 4096 * 512 * 2;
constexpr size_t WS_WGU = WS_WOM + (size_t)2 * 2048 * 2048 * 2;
constexpr size_t WS_WD = WS_WGU + (size_t)4 * 11264 * 2048 * 2;
constexpr size_t WS_X = WS_WD + (size_t)4 * 2048 * 5632 * 2;
constexpr size_t WS_H = WS_X + (size_t)MT * DM * 4;
constexpr size_t WS_Q = WS_H + (size_t)MT * DM * 2;
constexpr size_t WS_KB = WS_Q + (size_t)MT * 3072 * 2;
constexpr size_t WS_VB = WS_KB + (size_t)MT * 512 * 2;
constexpr size_t WS_CK = WS_VB + (size_t)MT * 512 * 2;
constexpr size_t WS_CV = WS_CK + (size_t)1024 * 512 * 2;
constexpr size_t WS_AO = WS_CV + (size_t)1024 * 512 * 2;
constexpr size_t WS_ACT = WS_AO + (size_t)MT * DM * 2;
constexpr size_t WS_RAW = WS_ACT + (size_t)MT * DFF * 2;
constexpr size_t WS_CQN = WS_RAW + (size_t)MT * 1280 * 4;
constexpr size_t WS_CKVN = WS_CQN + (size_t)MT * 512 * 2;
constexpr size_t WS_KPE = WS_CKVN + (size_t)MKV * 512 * 2;
constexpr size_t WS_KV = WS_KPE + (size_t)MKV * 64 * 2;
constexpr size_t WS_END = WS_KV + (size_t)MKV * 4096 * 2;
constexpr int CW_TMO = 0, CW_CODE = 1, CW_BAR = 4096;
constexpr int RING_BYTES = 131072, LDSCTL_OFF = RING_BYTES, MISC_OFF = LDSCTL_OFF + 320, LDS_BYTES = 147456;

__device__ __forceinline__ float shfl_xor_l(float v, int mask, int lane) { return __builtin_bit_cast(float, __builtin_amdgcn_ds_bpermute((lane ^ mask) << 2, __builtin_bit_cast(int, v))); }
__device__ __forceinline__ float wave_sum(float v, int lane) {
#pragma unroll
    for (int o = 1; o < 64; o <<= 1) v += shfl_xor_l(v, o, lane);
    return v;
}
__device__ __forceinline__ float wave_max(float v, int lane) {
#pragma unroll
    for (int o = 1; o < 64; o <<= 1) v = fmaxf(v, shfl_xor_l(v, o, lane));
    return v;
}
__device__ __forceinline__ float bf2f(unsigned short b) { return __builtin_bit_cast(float, ((unsigned)b) << 16); }
typedef unsigned v2u __attribute__((ext_vector_type(2)));
__device__ __forceinline__ v2u pk4(f32x4 v) { v2u r; r.x = pg8::cvt_pk_bf16(v[0], v[1]); r.y = pg8::cvt_pk_bf16(v[2], v[3]); return r; }

__device__ __forceinline__ int inv_perm32(int c) { return 16 * ((c >> 2) & 1) + 4 * (c >> 3) + (c & 3); }
__device__ __forceinline__ int dest_row(int kind, int n) {
    if (kind == 0) return n;
    return 256 * (n >> 7) + 32 * ((n & 127) >> 5) + inv_perm32(n & 31) + (kind == 2 ? 128 : 0);
}
__device__ __forceinline__ void p0_transpose_item(const float* W, int K, int N, bf16* WT, int kind, LAS float* scr, int item, int lane) {
    const int nblk = N / 32, kb = item / nblk, nb = item % nblk, k0 = 64 * kb, n0 = 32 * nb;
#pragma unroll 8
    for (int i = 0; i < 32; ++i) { const int kk = 2 * i + (lane >> 5); scr[kk * 33 + (lane & 31)] = W[(size_t)(k0 + kk) * N + n0 + (lane & 31)]; }
    LDS_WAIT(); asm volatile("" ::: "memory");
    const int c = lane & 7;
#pragma unroll
    for (int j = 0; j < 4; ++j) { const int n = (lane >> 3) + 8 * j; const LAS float* s = scr + (8 * c) * 33 + n;
        v4u o; o.x = pk2(s[0 * 33], s[1 * 33]); o.y = pk2(s[2 * 33], s[3 * 33]); o.z = pk2(s[4 * 33], s[5 * 33]); o.w = pk2(s[6 * 33], s[7 * 33]);
        *(GAS v4u*)(WT + (size_t)dest_row(kind, n0 + n) * K + k0 + 8 * c) = o; }
    LDS_WAIT(); asm volatile("" ::: "memory");
}
__device__ __forceinline__ void p0_gemv_item(const float* adaw, const float* c, const float* cctx, float* modp, LAS float* sl, int item, int lane) {
    const int ks = item & 7, cb = (item >> 3) % 48, l = item / 384;
    for (int i = lane; i < 768; i += 64) { const int cd = i >> 8, kk = i & 255; const float v = (cd == 0) ? cctx[256 * ks + kk] : c[(cd - 1) * 2048 + 256 * ks + kk]; sl[i] = v / (1.f + __expf(-v)); }
    LDS_WAIT(); asm volatile("" ::: "memory");
    const float* w = adaw + ((size_t)l * 2048 + 256 * ks) * NMOD + 256 * cb + 4 * lane;
    f32x4 a0 = {0.f, 0.f, 0.f, 0.f}, a1 = a0, a2 = a0;
#pragma unroll 8
    for (int r = 0; r < 256; ++r) { const f32x4 wv = *(const GAS f32x4*)(w + (size_t)r * NMOD); const float s0 = sl[r], s1 = sl[256 + r], s2 = sl[512 + r]; a0 += wv * s0; a1 += wv * s1; a2 += wv * s2; }
    float* o = modp + (((size_t)l * 8 + ks) * 3) * NMOD + 256 * cb + 4 * lane;
    *(GAS f32x4*)(o) = a0; *(GAS f32x4*)(o + NMOD) = a1; *(GAS f32x4*)(o + 2 * NMOD) = a2;
    LDS_WAIT(); asm volatile("" ::: "memory");
}
constexpr int GEMV_ITEMS = 4 * 48 * 8;
constexpr int TJ_ITEMS = 3072 + 2048 + 1088 + 768 + 1024 + 2048;
constexpr int TL_ITEMS = 3 * 5632;
constexpr int TR_ITEMS = 2 * TJ_ITEMS + 4 * TL_ITEMS;

__device__ __forceinline__ void norm_mod_phase(const float* xa, const float* xb, const float* gain, const float* mod_l, int sh_idx, int sc_idx, bf16* H, int gw, int NGW, int lane) {
    for (int m = gw; m < MT; m += NGW) {
        const float* xr = m < NCTXR ? xa + (size_t)m * DM : xb + (size_t)(m - NCTXR) * DM;
        const int cond = m < NCTXR ? 0 : (m < 6144 ? 1 : 2);
        const float* shv = mod_l + cond * NMOD + sh_idx * DM; const float* scv = mod_l + cond * NMOD + sc_idx * DM;
        f32x4 v[8]; float ss = 0.f;
#pragma unroll
        for (int j = 0; j < 8; ++j) { v[j] = ((const GAS f32x4*)xr)[lane + 64 * j]; ss += (v[j].x * v[j].x + v[j].y * v[j].y) + (v[j].z * v[j].z + v[j].w * v[j].w); }
        const float rstd = 1.f / sqrtf(wave_sum(ss, lane) * (1.f / DM) + RMS_EPS);
#pragma unroll
        for (int j = 0; j < 8; ++j) { const f32x4 g = ((const GAS f32x4*)gain)[lane + 64 * j], sc = ((const GAS f32x4*)scv)[lane + 64 * j], sh = ((const GAS f32x4*)shv)[lane + 64 * j];
            const f32x4 y = (v[j] * rstd) * g * (sc + 1.f) + sh;
            *(GAS v2u*)(H + (size_t)m * DM + 4 * (lane + 64 * j)) = pk4(y); }
    }
}
__device__ __forceinline__ void final_norm_phase(const float* X, const float* gain, float* out, int gw, int NGW, int lane) {
    for (int m = gw; m < MT; m += NGW) {
        const float* xr = X + (size_t)m * DM; f32x4 v[8]; float ss = 0.f;
#pragma unroll
        for (int j = 0; j < 8; ++j) { v[j] = ((const GAS f32x4*)xr)[lane + 64 * j]; ss += (v[j].x * v[j].x + v[j].y * v[j].y) + (v[j].z * v[j].z + v[j].w * v[j].w); }
        const float rstd = 1.f / sqrtf(wave_sum(ss, lane) * (1.f / DM) + RMS_EPS);
#pragma unroll
        for (int j = 0; j < 8; ++j) { const f32x4 g = ((const GAS f32x4*)gain)[lane + 64 * j]; ((GAS f32x4*)(out + (size_t)m * DM))[lane + 64 * j] = (v[j] * rstd) * g; }
    }
}
__device__ __forceinline__ void mla_norm_phase(const float* RAW, const float* qn, const float* kvn, const float* rope, const float* cache_ckv, const float* cache_kpe, int j,
                                               bf16* CQN, bf16* CKVN, bf16* KPE, float* out_ckv, float* out_kpe, int gw, int NGW, int lane) {
    for (int m = gw; m < MKV; m += NGW) {
        if (m < MT) {
            const float* r = RAW + (size_t)m * 1280;
            f32x4 q0 = ((const GAS f32x4*)r)[lane], q1 = ((const GAS f32x4*)r)[lane + 64];
            f32x4 k0 = ((const GAS f32x4*)(r + 512))[lane], k1 = ((const GAS f32x4*)(r + 512))[lane + 64];
            const float pe = r[1024 + lane];
            float sq = (q0.x * q0.x + q0.y * q0.y) + (q0.z * q0.z + q0.w * q0.w) + (q1.x * q1.x + q1.y * q1.y) + (q1.z * q1.z + q1.w * q1.w);
            float sk = (k0.x * k0.x + k0.y * k0.y) + (k0.z * k0.z + k0.w * k0.w) + (k1.x * k1.x + k1.y * k1.y) + (k1.z * k1.z + k1.w * k1.w);
            const float rq = 1.f / sqrtf(wave_sum(sq, lane) * (1.f / 512.f) + RMS_EPS), rk = 1.f / sqrtf(wave_sum(sk, lane) * (1.f / 512.f) + RMS_EPS);
            q0 = (q0 * rq) * ((const GAS f32x4*)qn)[lane]; q1 = (q1 * rq) * ((const GAS f32x4*)qn)[lane + 64];
            k0 = (k0 * rk) * ((const GAS f32x4*)kvn)[lane]; k1 = (k1 * rk) * ((const GAS f32x4*)kvn)[lane + 64];
            *(GAS v2u*)(CQN + (size_t)m * 512 + 4 * lane) = pk4(q0); *(GAS v2u*)(CQN + (size_t)m * 512 + 256 + 4 * lane) = pk4(q1);
            *(GAS v2u*)(CKVN + (size_t)m * 512 + 4 * lane) = pk4(k0); *(GAS v2u*)(CKVN + (size_t)m * 512 + 256 + 4 * lane) = pk4(k1);
            if (m < NCTXR) {
                const int b = m >> 8, s = m & 255; float* oc = out_ckv + ((size_t)(b * 2 + j) * 256 + s) * 512;
                ((GAS f32x4*)oc)[lane] = k0; ((GAS f32x4*)oc)[lane + 64] = k1;
                out_kpe[((size_t)(b * 2 + j) * 256 + s) * 64 + lane] = pe;
                KPE[(size_t)m * 64 + lane] = (bf16)f2bf(pe);
            } else {
                const int t = (m - NCTXR) & 2047; const int half = lane >> 5, i = lane & 15, part = (lane >> 4) & 1;
                const int pos = half ? (t & 63) : (t >> 6);
                const float cs = rope[pos * 16 + i], sn = rope[1024 + pos * 16 + i];
                const float other = shfl_xor_l(pe, 16, lane);
                const float o = part == 0 ? (pe * cs - other * sn) : (other * sn + pe * cs);
                KPE[(size_t)m * 64 + lane] = (bf16)f2bf(o);
            }
        } else {
            const int mm = m - MT, b = mm >> 8, s = mm & 255;
            const float* src = cache_ckv + ((size_t)(b * 2 + j) * 256 + s) * 512;
            const f32x4 k0 = ((const GAS f32x4*)src)[lane], k1 = ((const GAS f32x4*)src)[lane + 64];
            *(GAS v2u*)(CKVN + (size_t)m * 512 + 4 * lane) = pk4(k0); *(GAS v2u*)(CKVN + (size_t)m * 512 + 256 + 4 * lane) = pk4(k1);
            KPE[(size_t)m * 64 + lane] = (bf16)f2bf(cache_kpe[((size_t)(b * 2 + j) * 256 + s) * 64 + lane]);
        }
    }
}

using pg8::Unit;
struct EpiResid {
    static constexpr bool PERM = false, AFTER_DRAIN = false;
    const float* xa; const float* xb; float* xo; const float* mod_l; int gidx;
    __device__ __forceinline__ void operator()(const f32x4 (&acc)[2][2][4][2], const Unit& u, int wr, int wc, int fr, int fq) const {
        const int row0 = u.pm * 256 + wr * 64 + fr, col0 = u.pn * 256 + wc * 32 + 4 * fq;
        const int cond = u.pm < 16 ? 0 : (u.pm < 24 ? 1 : 2);
        const float* gv = mod_l + cond * NMOD + gidx * DM + col0;
        f32x4 g[2][2];
#pragma unroll
        for (int bj = 0; bj < 2; ++bj)
#pragma unroll
            for (int n = 0; n < 2; ++n) g[bj][n] = *(const GAS f32x4*)(gv + bj * 128 + n * 16);
#pragma unroll
        for (int ai = 0; ai < 2; ++ai)
#pragma unroll
            for (int m = 0; m < 4; ++m) { const int row = row0 + ai * 128 + m * 16;
                const float* xi = (u.pm < 16 ? xa + (size_t)row * DM : xb + (size_t)(row - NCTXR) * DM) + col0; float* xw = xo + (size_t)row * DM + col0;
#pragma unroll
                for (int bj = 0; bj < 2; ++bj)
#pragma unroll
                    for (int n = 0; n < 2; ++n) { const f32x4 x = *(const GAS f32x4*)(xi + bj * 128 + n * 16); *(GAS f32x4*)(xw + bj * 128 + n * 16) = x + g[bj][n] * acc[ai][bj][m][n]; }
                asm volatile("" ::: "memory"); }
    }
};
struct EpiSwiGLU {
    static constexpr bool PERM = false, AFTER_DRAIN = false;
    bf16* ACT;
    __device__ __forceinline__ void operator()(const f32x4 (&acc)[2][2][4][2], const Unit& u, int wr, int wc, int fr, int fq) const {
        const int row0 = u.pm * 256 + wr * 64 + fr, colb = u.pn * 128 + wc * 32 + 8 * fq;
#pragma unroll
        for (int ai = 0; ai < 2; ++ai)
#pragma unroll
            for (int m = 0; m < 4; ++m) { const int row = row0 + ai * 128 + m * 16; f32x4 a[2];
#pragma unroll
                for (int n = 0; n < 2; ++n) { const f32x4 gt = acc[ai][0][m][n], up = acc[ai][1][m][n];
#pragma unroll
                    for (int e = 0; e < 4; ++e) a[n][e] = gt[e] * __builtin_amdgcn_rcpf(1.f + __expf(-gt[e])) * up[e]; }
                v4u w; w.x = pg8::cvt_pk_bf16(a[0][0], a[0][1]); w.y = pg8::cvt_pk_bf16(a[0][2], a[0][3]); w.z = pg8::cvt_pk_bf16(a[1][0], a[1][1]); w.w = pg8::cvt_pk_bf16(a[1][2], a[1][3]);
                *(GAS v4u*)(ACT + (size_t)row * DFF + colb) = w; }
    }
};
struct EpiQkvWin {
    static constexpr bool PERM = false, AFTER_DRAIN = false;
    bf16* Q; bf16* Kb; bf16* Vb; float* outK; float* outV; const float* rope; int j;
    __device__ __forceinline__ void operator()(const f32x4 (&acc)[2][2][4][2], const Unit& u, int wr, int wc, int fr, int fq) const {
        const int row0 = u.pm * 256 + wr * 64 + fr, colt = u.pn * 256; const bool latent = u.pm >= 16;
        bf16* dst; int pitch, cbase; float* of = nullptr;
        if (colt < 2048) { dst = Q; pitch = 2048; cbase = colt; } else if (colt < 2560) { dst = Kb; pitch = 512; cbase = colt - 2048; of = outK; } else { dst = Vb; pitch = 512; cbase = colt - 2560; of = outV; }
        const bool dorope = latent && colt < 2560; const int c0 = cbase + wc * 32 + 4 * fq;
#pragma unroll
        for (int ai = 0; ai < 2; ++ai)
#pragma unroll
            for (int m = 0; m < 4; ++m) { const int row = row0 + ai * 128 + m * 16;
                f32x4 cs = {1.f, 1.f, 1.f, 1.f}, sn = {0.f, 0.f, 0.f, 0.f};
                if (dorope) { const int t = (row - NCTXR) & 2047; const int pos = (wc & 1) ? (t & 63) : (t >> 6); cs = *(const GAS f32x4*)(rope + pos * 16 + 4 * fq); sn = *(const GAS f32x4*)(rope + 1024 + pos * 16 + 4 * fq); }
#pragma unroll
                for (int bj = 0; bj < 2; ++bj) { const f32x4 x1 = acc[ai][bj][m][0], x2 = acc[ai][bj][m][1];
                    const f32x4 o1 = x1 * cs - x2 * sn, o2 = x1 * sn + x2 * cs;
                    bf16* d = dst + (size_t)row * pitch + c0 + bj * 128;
                    *(GAS v2u*)(d) = pk4(o1); *(GAS v2u*)(d + 16) = pk4(o2);
                    if (!latent && of) { const int b = row >> 8, s = row & 255; float* o = of + ((size_t)(b * 2 + j) * 256 + s) * 512 + c0 + bj * 128; *(GAS f32x4*)(o) = o1; *(GAS f32x4*)(o + 16) = o2; } }
            }
    }
};
struct EpiRawF32 {
    static constexpr bool PERM = false, AFTER_DRAIN = false;
    float* C; int ldc;
    __device__ __forceinline__ void operator()(const f32x4 (&acc)[2][2][4][2], const Unit& u, int wr, int wc, int fr, int fq) const {
        const int row0 = u.pm * 256 + wr * 64 + fr, col0 = u.pn * 256 + wc * 32 + 4 * fq;
#pragma unroll
        for (int ai = 0; ai < 2; ++ai)
#pragma unroll
            for (int m = 0; m < 4; ++m) { float* rowp = C + (size_t)(row0 + ai * 128 + m * 16) * ldc + col0;
#pragma unroll
                for (int bj = 0; bj < 2; ++bj)
#pragma unroll
                    for (int n = 0; n < 2; ++n) *(GAS f32x4*)(rowp + bj * 128 + n * 16) = acc[ai][bj][m][n]; }
    }
};
struct EpiQb {
    static constexpr bool PERM = false, AFTER_DRAIN = false;
    bf16* Qm; const float* rope;
    __device__ __forceinline__ void operator()(const f32x4 (&acc)[2][2][4][2], const Unit& u, int wr, int wc, int fr, int fq) const {
        const int row0 = u.pm * 256 + wr * 64 + fr, colt = u.pn * 256; const bool latent = u.pm >= 16;
        int rk[2];
#pragma unroll
        for (int bj = 0; bj < 2; ++bj) { const int gm = ((colt + bj * 128 + wc * 32) >> 5) % 6; rk[bj] = latent ? (gm == 4 ? 1 : (gm == 5 ? 2 : 0)) : 0; }
        const int c0 = colt + wc * 32 + 4 * fq;
#pragma unroll
        for (int ai = 0; ai < 2; ++ai)
#pragma unroll
            for (int m = 0; m < 4; ++m) { const int row = row0 + ai * 128 + m * 16; const int t = (row - NCTXR) & 2047;
#pragma unroll
                for (int bj = 0; bj < 2; ++bj) { f32x4 cs = {1.f, 1.f, 1.f, 1.f}, sn = {0.f, 0.f, 0.f, 0.f};
                    if (rk[bj]) { const int pos = rk[bj] == 2 ? (t & 63) : (t >> 6); cs = *(const GAS f32x4*)(rope + pos * 16 + 4 * fq); sn = *(const GAS f32x4*)(rope + 1024 + pos * 16 + 4 * fq); }
                    const f32x4 x1 = acc[ai][bj][m][0], x2 = acc[ai][bj][m][1];
                    const f32x4 o1 = x1 * cs - x2 * sn, o2 = x1 * sn + x2 * cs;
                    bf16* d = Qm + (size_t)row * 3072 + c0 + bj * 128;
                    *(GAS v2u*)(d) = pk4(o1); *(GAS v2u*)(d + 16) = pk4(o2); }
            }
    }
};
struct EpiBf16Plain {
    static constexpr bool PERM = false, AFTER_DRAIN = false;
    bf16* O; int ldc;
    __device__ __forceinline__ void operator()(const f32x4 (&acc)[2][2][4][2], const Unit& u, int wr, int wc, int fr, int fq) const {
        const int row0 = u.pm * 256 + wr * 64 + fr, col0 = u.pn * 256 + wc * 32 + 4 * fq;
#pragma unroll
        for (int ai = 0; ai < 2; ++ai)
#pragma unroll
            for (int m = 0; m < 4; ++m) { bf16* rowp = O + (size_t)(row0 + ai * 128 + m * 16) * ldc + col0;
#pragma unroll
                for (int bj = 0; bj < 2; ++bj)
#pragma unroll
                    for (int n = 0; n < 2; ++n) *(GAS v2u*)(rowp + bj * 128 + n * 16) = pk4(acc[ai][bj][m][n]); }
    }
};

struct KSeg { const bf16* k; const bf16* kr; const bf16* v; int ks, krs, vs, n, pos0; };
template <int DN, int DR, int DV>
__device__ __forceinline__ void attn_unit_naive(LAS float* sc, LAS float* qs, const bf16* qb, int qpitch, int tlog, bf16* ob, int opitch, int qpos0,
                                                const KSeg& s0, const KSeg& s1, int nseg, float sl2, const float* sink, int wave, int lane) {
    constexpr int DQ = DN + DR;
    for (int rr = 0; rr < 32; ++rr) {
        const int r = wave * 32 + rr, tt = r & ((1 << tlog) - 1), g = r >> tlog;
        const bf16* q = qb + (size_t)tt * qpitch + g * DQ;
        for (int d = lane; d < DQ; d += 64) qs[d] = bf2f(q[d]);
        LDS_WAIT(); asm volatile("" ::: "memory");
        float mx = sink ? sink[g] * LOG2E : -1e30f;
        int off = 0;
        for (int si = 0; si < nseg; ++si) { const KSeg& S = si ? s1 : s0;
            for (int k0 = 0; k0 < S.n; k0 += 64) { const int key = k0 + lane; float a = -INFINITY;
                if (key < S.n) { const bf16* kp = S.k + (size_t)key * S.ks; a = 0.f;
                    for (int d = 0; d < DN; d += 8) { const v4u kv = *(const v4u*)(kp + d); const unsigned w[4] = {kv.x, kv.y, kv.z, kv.w};
#pragma unroll
                        for (int e = 0; e < 4; ++e) { a += qs[d + 2 * e] * __builtin_bit_cast(float, w[e] << 16); a += qs[d + 2 * e + 1] * __builtin_bit_cast(float, w[e] & 0xffff0000u); } }
                    if (DR) { const bf16* rp = S.kr + (size_t)key * S.krs;
                        for (int d = 0; d < DR; d += 8) { const v4u kv = *(const v4u*)(rp + d); const unsigned w[4] = {kv.x, kv.y, kv.z, kv.w};
#pragma unroll
                            for (int e = 0; e < 4; ++e) { a += qs[DN + d + 2 * e] * __builtin_bit_cast(float, w[e] << 16); a += qs[DN + d + 2 * e + 1] * __builtin_bit_cast(float, w[e] & 0xffff0000u); } } }
                    a *= sl2;
                    if (S.pos0 >= 0) { const int dp = S.pos0 + key - (qpos0 + tt); if (dp > 128 || dp < -128) a = -INFINITY; }
                }
                sc[off + key] = a; mx = fmaxf(mx, a); }
            off += (S.n + 63) & ~63; }
        mx = wave_max(mx, lane);
        LDS_WAIT(); asm volatile("" ::: "memory");
        float l = 0.f;
        for (int i = lane; i < off; i += 64) { const float pv = __builtin_amdgcn_exp2f(sc[i] - mx); sc[i] = pv; l += pv; }
        l = wave_sum(l, lane) + (sink ? __builtin_amdgcn_exp2f(sink[g] * LOG2E - mx) : 0.f);
        LDS_WAIT(); asm volatile("" ::: "memory");
        float o[DV / 64];
#pragma unroll
        for (int e = 0; e < DV / 64; ++e) o[e] = 0.f;
        off = 0;
        for (int si = 0; si < nseg; ++si) { const KSeg& S = si ? s1 : s0;
            for (int key = 0; key < S.n; ++key) { const float pv = sc[off + key]; const bf16* vp = S.v + (size_t)key * S.vs;
#pragma unroll
                for (int e = 0; e < DV / 64; ++e) o[e] += pv * bf2f(vp[lane + 64 * e]); }
            off += (S.n + 63) & ~63; }
        const float inv = 1.f / l;
#pragma unroll
        for (int e = 0; e < DV / 64; ++e) ob[(size_t)tt * opitch + g * DV + lane + 64 * e] = (bf16)f2bf(o[e] * inv);
        LDS_WAIT(); asm volatile("" ::: "memory");
    }
}

typedef float f32x16 __attribute__((ext_vector_type(16)));
typedef short s16x4 __attribute__((ext_vector_type(4)));
template <int DN, int DR, int DV>
__device__ __forceinline__ void attn_unit_mfma(LAS unsigned char* lds, const bf16* qb, int qpitch, int tlog, bf16* ob, int opitch, int qpos0,
                                               const KSeg& s0, const KSeg& s1, int nseg, float sl2, const float* sink, int tid) {
    constexpr int DQ = DN + DR, KST = DQ * 2 + 16, VST = (DV == 64 ? 192 : 320);
    constexpr int KT_BYTES = 64 * KST, VT_BYTES = 64 * VST, BUFB = KT_BYTES + VT_BYTES;
    constexpr int CPR_V = DV / 8, NPT = 64 * (DN / 8) / 512, KPT = NPT + (DR ? 1 : 0), VPT = 64 * CPR_V / 512;
    static_assert(2 * BUFB <= RING_BYTES && NPT * 512 == 64 * (DN / 8) && (DR == 0 || DR == 64) && VPT * 512 == 64 * CPR_V, "attention tile geometry");
    const int lane = tid & 63, wave = __builtin_amdgcn_readfirstlane(tid >> 6), q = lane & 31, h = lane >> 5;
    const int r = wave * 32 + q, tt = r & ((1 << tlog) - 1), g = r >> tlog;
    bf16x8 qf[DQ / 16];
    { const bf16* qrow = qb + (size_t)tt * qpitch + g * DQ + 8 * h;
#pragma unroll
      for (int ks = 0; ks < DQ / 16; ++ks) qf[ks] = *(const GAS bf16x8*)(qrow + 16 * ks); }
    float m, l;
    if (sink) { m = sink[g] * LOG2E; l = h == 0 ? 1.f : 0.f; } else { m = -1e30f; l = 0.f; }
    f32x16 o[DV / 32];
#pragma unroll
    for (int db = 0; db < DV / 32; ++db)
#pragma unroll
        for (int e = 0; e < 16; ++e) o[db][e] = 0.f;
    const int T0 = s0.n >> 6, T = T0 + (nseg > 1 ? (s1.n >> 6) : 0);
    v4u kreg[KPT], vreg[VPT];
    const int kq_off = q * KST + 16 * h;
    const int vt_off = (4 * h + ((lane & 15) >> 2)) * VST + (16 * ((lane >> 4) & 1) + 4 * (lane & 3)) * 2;
#define AT_LOAD(t_) do { const int t__ = (t_); const bool first__ = t__ < T0; const KSeg& S__ = first__ ? s0 : s1; const int k0__ = (first__ ? t__ : t__ - T0) * 64; \
        _Pragma("unroll") for (int i__ = 0; i__ < NPT; ++i__) { const int c__ = tid + 512 * i__, key__ = c__ / (DN / 8), cc__ = c__ % (DN / 8); \
            kreg[i__] = *(const GAS v4u*)((const GAS char*)S__.k + (unsigned)(((k0__ + key__) * S__.ks + cc__ * 8) * 2)); } \
        if (DR) { const int key__ = tid >> 3, cc__ = tid & 7; kreg[NPT] = *(const GAS v4u*)((const GAS char*)S__.kr + (unsigned)(((k0__ + key__) * S__.krs + cc__ * 8) * 2)); } \
        _Pragma("unroll") for (int i__ = 0; i__ < VPT; ++i__) { const int c__ = tid + 512 * i__, key__ = c__ / CPR_V, cc__ = c__ % CPR_V; \
            vreg[i__] = *(const GAS v4u*)((const GAS char*)S__.v + (unsigned)(((k0__ + key__) * S__.vs + cc__ * 8) * 2)); } } while (0)
#define AT_WRITE(buf_) do { LAS unsigned char* kb__ = lds + (buf_) * BUFB; \
        _Pragma("unroll") for (int i__ = 0; i__ < NPT; ++i__) { const int c__ = tid + 512 * i__, key__ = c__ / (DN / 8), cc__ = c__ % (DN / 8); *(LAS v4u*)(kb__ + key__ * KST + cc__ * 16) = kreg[i__]; } \
        if (DR) { const int key__ = tid >> 3, cc__ = tid & 7; *(LAS v4u*)(kb__ + key__ * KST + (DN / 8 + cc__) * 16) = kreg[NPT]; } \
        _Pragma("unroll") for (int i__ = 0; i__ < VPT; ++i__) { const int c__ = tid + 512 * i__, key__ = c__ / CPR_V, cc__ = c__ % CPR_V; *(LAS v4u*)(kb__ + KT_BYTES + key__ * VST + cc__ * 16) = vreg[i__]; } } while (0)
    AT_LOAD(0); AT_WRITE(0); __syncthreads();
    for (int t = 0; t < T; ++t) {
        if (t + 1 < T) AT_LOAD(t + 1);
        const LAS unsigned char* Kl = lds + (t & 1) * BUFB; const LAS unsigned char* Vl = Kl + KT_BYTES;
        f32x16 s[2];
#pragma unroll
        for (int kb = 0; kb < 2; ++kb) {
#pragma unroll
            for (int e = 0; e < 16; ++e) s[kb][e] = 0.f;
#pragma unroll
            for (int ks = 0; ks < DQ / 16; ++ks) { const bf16x8 kf = *(const LAS bf16x8*)(Kl + kq_off + 32 * kb * KST + 32 * ks); s[kb] = __builtin_amdgcn_mfma_f32_32x32x16_bf16(kf, qf[ks], s[kb], 0, 0, 0); } }
        const bool first = t < T0; const int pos0 = first ? s0.pos0 : s1.pos0; const int k0 = (first ? t : t - T0) * 64;
        float mx = -INFINITY;
        if (pos0 >= 0) { const int rel = pos0 + k0 + 4 * h - (qpos0 + tt);
#pragma unroll
            for (int kb = 0; kb < 2; ++kb)
#pragma unroll
                for (int e = 0; e < 16; ++e) { const int dp = rel + 32 * kb + (e & 3) + 8 * (e >> 2); float v = s[kb][e] * sl2; if (dp > 128 || dp < -128) v = -INFINITY; s[kb][e] = v; mx = fmaxf(mx, v); }
        } else {
#pragma unroll
            for (int kb = 0; kb < 2; ++kb)
#pragma unroll
                for (int e = 0; e < 16; ++e) { const float v = s[kb][e] * sl2; s[kb][e] = v; mx = fmaxf(mx, v); } }
        mx = fmaxf(mx, shfl_xor_l(mx, 32, lane));
        const float mn = fmaxf(m, mx), alpha = __builtin_amdgcn_exp2f(m - mn); m = mn;
        float psum = 0.f;
#pragma unroll
        for (int kb = 0; kb < 2; ++kb)
#pragma unroll
            for (int e = 0; e < 16; ++e) { const float pv = __builtin_amdgcn_exp2f(s[kb][e] - mn); s[kb][e] = pv; psum += pv; }
        l = l * alpha + psum;
#pragma unroll
        for (int db = 0; db < DV / 32; ++db) o[db] = o[db] * alpha;
#pragma unroll
        for (int kb = 0; kb < 2; ++kb)
#pragma unroll
            for (int sg = 0; sg < 2; ++sg) {
                v4u pw; pw.x = pg8::cvt_pk_bf16(s[kb][8 * sg + 0], s[kb][8 * sg + 1]); pw.y = pg8::cvt_pk_bf16(s[kb][8 * sg + 2], s[kb][8 * sg + 3]);
                pw.z = pg8::cvt_pk_bf16(s[kb][8 * sg + 4], s[kb][8 * sg + 5]); pw.w = pg8::cvt_pk_bf16(s[kb][8 * sg + 6], s[kb][8 * sg + 7]);
                const bf16x8 pf = __builtin_bit_cast(bf16x8, pw);
#pragma unroll
                for (int db = 0; db < DV / 32; ++db) { const LAS unsigned char* vp = Vl + vt_off + (32 * kb + 16 * sg) * VST + 64 * db;
                    const s16x4 lo = __builtin_amdgcn_ds_read_tr16_b64_v4i16((LAS s16x4*)vp), hi = __builtin_amdgcn_ds_read_tr16_b64_v4i16((LAS s16x4*)(vp + 8 * VST));
                    const bf16x8 vf = {lo[0], lo[1], lo[2], lo[3], hi[0], hi[1], hi[2], hi[3]};
                    o[db] = __builtin_amdgcn_mfma_f32_32x32x16_bf16(vf, pf, o[db], 0, 0, 0); } }
        if (t + 1 < T) AT_WRITE((t + 1) & 1);
        __syncthreads();
    }
#undef AT_LOAD
#undef AT_WRITE
    l += shfl_xor_l(l, 32, lane);
    const float inv = 1.f / l;
    bf16* orow = ob + (size_t)tt * opitch + g * DV + 4 * h;
#pragma unroll
    for (int db = 0; db < DV / 32; ++db)
#pragma unroll
        for (int gq = 0; gq < 4; ++gq) { const f32x4 v = {o[db][4 * gq] * inv, o[db][4 * gq + 1] * inv, o[db][4 * gq + 2] * inv, o[db][4 * gq + 3] * inv}; *(GAS v2u*)(orow + 32 * db + 8 * gq) = pk4(v); }
}

#ifndef ATTN_NAIVE
#define ATTN_NAIVE 0
#endif
#ifndef ATTN_NAIVE_WIN
#define ATTN_NAIVE_WIN 0
#endif
#ifndef ATTN_NAIVE_MLA
#define ATTN_NAIVE_MLA 0
#endif
#ifndef MK_PER_PHASE
#define MK_PER_PHASE 0
#endif
constexpr int NPHASES = 2 + 2 * (7 + 9) + 1;
struct Params { const float* in[25]; float* out; unsigned char* ws; int lo, hi; };
typedef pg8::StaticOrder SOrd;

#define CAS __attribute__((address_space(4)))
__device__ __forceinline__ const CAS char* kernarg_l() { const CAS char* ka = (const CAS char*)__builtin_amdgcn_kernarg_segment_ptr(); asm volatile("" : "+s"(ka)); return ka; }
__global__ void __launch_bounds__(512, 2) fwd_kernel(Params p) {
    extern __shared__ __attribute__((aligned(16))) unsigned char lds_raw[];
    LAS unsigned char* lds = (LAS unsigned char*)lds_raw;
    const int tid0 = threadIdx.x;
    const int G = gridDim.x, wave0 = __builtin_amdgcn_readfirstlane(tid0 >> 6);
    volatile LAS unsigned* MISC = (volatile LAS unsigned*)(lds + MISC_OFF);
    for (int u = tid0; u < (LDS_BYTES - LDSCTL_OFF) / 4; u += 512) ((LAS unsigned*)(lds + LDSCTL_OFF))[u] = 0u;
    __syncthreads();
    unsigned char* ws = p.ws; gu32* ctl = (gu32*)(ws + WS_CTL);
    const int lo = p.lo, hi = p.hi;
    XcdBarrier bar; bar.bar = (unsigned*)(ctl + CW_BAR); bar.x = 0; bar.st = MISC + 8;
    if (hi - lo > 1) bar = xcd_barrier_post((unsigned*)(ctl + CW_BAR), MISC + 8);

#define INP(k) (*(const float* const CAS*)(kernarg_l() + 8 * (k)))
#define WSP(T, OFF) ((T*)(wsl + (OFF)))
    float* out_ = p.out;
    int ph = 0;
#define PH_BEGIN { const bool run_ = (ph >= lo) && (ph < hi); if (run_) { unsigned char* wsl = ws; float* out = out_; int Gl = G, bx = (int)blockIdx.x, wv_ = wave0, tidl; asm volatile("" : "+s"(wsl), "+s"(out), "+s"(Gl), "+s"(bx), "+s"(wv_)); asm volatile("v_mbcnt_lo_u32_b32 %0, -1, 0\n\tv_mbcnt_hi_u32_b32 %0, -1, %0" : "=v"(tidl)); tidl += wv_ * 64; const int tid = tidl, lane = tidl & 63, wave = __builtin_amdgcn_readfirstlane(tidl >> 6), gw = bx * 8 + wave, NGW = Gl * 8; (void)tid; (void)lane; (void)gw; (void)NGW;
#define PH_END } if (run_ && (ph + 1 < hi)) xcd_barrier(bar); ++ph; }

    PH_BEGIN
        LAS float* scr = (LAS float*)(lds + wave * 16384);
        for (int it = gw; it < GEMV_ITEMS + TR_ITEMS; it += NGW) {
            if (it < GEMV_ITEMS) { p0_gemv_item(INP(8), INP(6), INP(7), WSP(float, WS_MODP), scr, it, lane); continue; }
            int r = it - GEMV_ITEMS;
            if (r < 2 * TJ_ITEMS) { const int j = r / TJ_ITEMS; r -= j * TJ_ITEMS;
                if (r < 3072) { p0_transpose_item(INP(12) + (size_t)j * 2048 * 3072, 2048, 3072, WSP(bf16, WS_WQKV) + (size_t)j * 3072 * 2048, 0, scr, r, lane); continue; } r -= 3072;
                if (r < 2048) { p0_transpose_item(INP(13) + (size_t)j * 2048 * 2048, 2048, 2048, WSP(bf16, WS_WOW) + (size_t)j * 2048 * 2048, 0, scr, r, lane); continue; } r -= 2048;
                if (r < 1088) { p0_transpose_item(INP(15) + (size_t)j * 2048 * 1088, 2048, 1088, WSP(bf16, WS_WIN) + (size_t)j * 1280 * 2048, 0, scr, r, lane); continue; } r -= 1088;
                if (r < 768) { p0_transpose_item(INP(17) + (size_t)j * 512 * 3072, 512, 3072, WSP(bf16, WS_WQB) + (size_t)j * 3072 * 512, 0, scr, r, lane); continue; } r -= 768;
                if (r < 1024) { p0_transpose_item(INP(19) + (size_t)j * 512 * 4096, 512, 4096, WSP(bf16, WS_WKVB) + (size_t)j * 4096 * 512, 0, scr, r, lane); continue; } r -= 1024;
                p0_transpose_item(INP(20) + (size_t)j * 2048 * 2048, 2048, 2048, WSP(bf16, WS_WOM) + (size_t)j * 2048 * 2048, 0, scr, r, lane); continue; }
            r -= 2 * TJ_ITEMS; { const int l = r / TL_ITEMS; r -= l * TL_ITEMS;
                if (r < 5632) { p0_transpose_item(INP(21) + (size_t)l * 2048 * 5632, 2048, 5632, WSP(bf16, WS_WGU) + (size_t)l * 11264 * 2048, 1, scr, r, lane); continue; } r -= 5632;
                if (r < 5632) { p0_transpose_item(INP(22) + (size_t)l * 2048 * 5632, 2048, 5632, WSP(bf16, WS_WGU) + (size_t)l * 11264 * 2048, 2, scr, r, lane); continue; } r -= 5632;
                p0_transpose_item(INP(23) + (size_t)l * 5632 * 2048, 5632, 2048, WSP(bf16, WS_WD) + (size_t)l * 2048 * 5632, 0, scr, r, lane); }
        }
    PH_END
    PH_BEGIN
        const int gt = bx * 512 + tid, NT = Gl * 512;
        for (int idx = gt; idx < 4 * 3 * NMOD; idx += NT) { const int l = idx / (3 * NMOD), rem = idx - l * 3 * NMOD, cd = rem / NMOD, col = rem - cd * NMOD;
            float s = INP(9)[l * NMOD + col];
#pragma unroll
            for (int ks = 0; ks < 8; ++ks) s += WSP(float, WS_MODP)[(((size_t)l * 8 + ks) * 3 + cd) * NMOD + col];
            WSP(float, WS_MOD)[idx] = s; }
        for (int idx = gt; idx < 1024 * 512 / 4; idx += NT) { *(GAS v2u*)(WSP(bf16, WS_CK) + 4 * (size_t)idx) = pk4(((const GAS f32x4*)INP(2))[idx]); *(GAS v2u*)(WSP(bf16, WS_CV) + 4 * (size_t)idx) = pk4(((const GAS f32x4*)INP(3))[idx]); }
        if (bx == 0) for (int idx = tid; idx < 1024; idx += 512) { const int pos = idx >> 4, i = idx & 15; const float fr_ = powf(10000.f, -(float)i * (1.f / 16.f)); const float ang = (float)pos * fr_;
            WSP(float, WS_ROPE)[idx] = cosf(ang); WSP(float, WS_ROPE)[1024 + idx] = sinf(ang); }
    PH_END

    for (int layer = 0; layer < 4; ++layer) {
        const int j = layer >> 1; const bool is_win = !(layer & 1);
#define X_ WSP(float, WS_X)
#define XA_ (layer == 0 ? INP(0) : (const float*)X_)
#define XB_ (layer == 0 ? INP(1) : (const float*)(X_ + (size_t)NCTXR * DM))
#define MODL_ (WSP(float, WS_MOD) + (size_t)layer * 3 * NMOD)
        PH_BEGIN norm_mod_phase(XA_, XB_, INP(10) + layer * DM, MODL_, 0, 1, WSP(bf16, WS_H), gw, NGW, lane); PH_END
        if (is_win) {
            PH_BEGIN
                pg8::Gemm g{WSP(bf16, WS_H), WSP(bf16, WS_WQKV) + (size_t)j * 3072 * 2048, MT, 3072, DM}; SOrd S; S.init(MT, 3072, Gl, bx);
                EpiQkvWin E{WSP(bf16, WS_Q), WSP(bf16, WS_KB), WSP(bf16, WS_VB), out + O_WK, out + O_WV, WSP(float, WS_ROPE), j};
                pg8::gemm_phase<EpiQkvWin, SOrd, true, true>(lds, g, S, E, tid);
            PH_END
            PH_BEGIN
                LAS float* sc = (LAS float*)(lds + wave * 9472); LAS float* qs = (LAS float*)(lds + 75776 + wave * 768); (void)sc; (void)qs;
                bf16* Q = WSP(bf16, WS_Q); bf16* Kb = WSP(bf16, WS_KB); bf16* Vb = WSP(bf16, WS_VB); bf16* CK = WSP(bf16, WS_CK); bf16* CV = WSP(bf16, WS_CV); bf16* AO = WSP(bf16, WS_AO);
                for (int u = bx; u < 1024; u += Gl) {
                    KSeg s0, s1; int nseg, qpos0 = 0; const bf16* qb; bf16* ob;
                    if (u < 512) { const int b = u >> 5, kvh = (u >> 2) & 7, tq = u & 3; const size_t row0 = (size_t)b * 256 + tq * 64;
                        qb = Q + row0 * 2048 + kvh * 256; ob = AO + row0 * 2048 + kvh * 256;
                        s0 = KSeg{Kb + (size_t)b * 256 * 512 + kvh * 64, nullptr, Vb + (size_t)b * 256 * 512 + kvh * 64, 512, 0, 512, 256, -1}; s1 = s0; nseg = 1;
                    } else { const int v = u - 512, b = v >> 8, kvh = (v >> 5) & 7, tq = v & 31; const size_t row0 = (size_t)NCTXR + b * 2048 + tq * 64;
                        qb = Q + row0 * 2048 + kvh * 256; ob = AO + row0 * 2048 + kvh * 256; qpos0 = tq * 64;
                        const size_t cb = (size_t)(b * 2 + j) * 256 * 512 + kvh * 64;
                        s0 = KSeg{CK + cb, nullptr, CV + cb, 512, 0, 512, 256, -1};
                        const int lo_k = max(0, tq * 64 - 128), hi_k = min(2048, tq * 64 + 192); const size_t kr = ((size_t)NCTXR + b * 2048 + lo_k) * 512 + kvh * 64;
                        s1 = KSeg{Kb + kr, nullptr, Vb + kr, 512, 0, 512, hi_k - lo_k, lo_k}; nseg = 2; }
                    const float* sinkp = INP(14) + j * 32 + ((u < 512 ? (u >> 2) : ((u - 512) >> 5)) & 7) * 4;
#if ATTN_NAIVE || ATTN_NAIVE_WIN
                    attn_unit_naive<64, 0, 64>(sc, qs, qb, 2048, 6, ob, 2048, qpos0, s0, s1, nseg, WIN_SL2, sinkp, wave, lane);
#else
                    attn_unit_mfma<64, 0, 64>(lds, qb, 2048, 6, ob, 2048, qpos0, s0, s1, nseg, WIN_SL2, sinkp, tid);
#endif
                }
            PH_END
        } else {
            PH_BEGIN
                pg8::Gemm g{WSP(bf16, WS_H), WSP(bf16, WS_WIN) + (size_t)j * 1280 * 2048, MT, 1280, DM}; SOrd S; S.init(MT, 1280, Gl, bx);
                EpiRawF32 E{WSP(float, WS_RAW), 1280};
                pg8::gemm_phase<EpiRawF32, SOrd, true, true>(lds, g, S, E, tid);
            PH_END
            PH_BEGIN mla_norm_phase(WSP(float, WS_RAW), INP(16) + j * 512, INP(18) + j * 512, WSP(float, WS_ROPE), INP(4), INP(5), j, WSP(bf16, WS_CQN), WSP(bf16, WS_CKVN), WSP(bf16, WS_KPE), out + O_CKV, out + O_KPE, gw, NGW, lane); PH_END
            PH_BEGIN
                { pg8::Gemm g{WSP(bf16, WS_CQN), WSP(bf16, WS_WQB) + (size_t)j * 3072 * 512, MT, 3072, 512}; SOrd S; S.init(MT, 3072, Gl, bx);
                  EpiQb E{WSP(bf16, WS_Q), WSP(float, WS_ROPE)}; pg8::gemm_phase<EpiQb, SOrd, true, true>(lds, g, S, E, tid); }
                { pg8::Gemm g{WSP(bf16, WS_CKVN), WSP(bf16, WS_WKVB) + (size_t)j * 4096 * 512, MKV, 4096, 512}; SOrd S; S.init(MKV, 4096, Gl, bx);
                  EpiBf16Plain E{WSP(bf16, WS_KV), 4096}; pg8::gemm_phase<EpiBf16Plain, SOrd, true, true>(lds, g, S, E, tid); }
            PH_END
            PH_BEGIN
                LAS float* sc = (LAS float*)(lds + wave * 9472); LAS float* qs = (LAS float*)(lds + 75776 + wave * 768); (void)sc; (void)qs;
                bf16* Q = WSP(bf16, WS_Q); bf16* KV = WSP(bf16, WS_KV); bf16* KPE = WSP(bf16, WS_KPE); bf16* AO = WSP(bf16, WS_AO);
                for (int u = bx; u < 512; u += Gl) {
                    KSeg s0, s1; int nseg; const bf16* qb; bf16* ob;
                    if (u < 256) { const int b = u >> 4, h = u & 15; const size_t row0 = (size_t)b * 256;
                        qb = Q + row0 * 3072 + h * 192; ob = AO + row0 * 2048 + h * 128;
                        s0 = KSeg{KV + row0 * 4096 + h * 256, KPE + row0 * 64, KV + row0 * 4096 + h * 256 + 128, 4096, 64, 4096, 256, -1}; s1 = s0; nseg = 1;
                    } else { const int v = u - 256, b = v >> 7, h = (v >> 3) & 15, tq = v & 7; const size_t row0 = (size_t)NCTXR + b * 2048 + tq * 256;
                        qb = Q + row0 * 3072 + h * 192; ob = AO + row0 * 2048 + h * 128;
                        const size_t kr0 = (size_t)NCTXR + b * 2048, cr0 = (size_t)MT + b * 256;
                        s0 = KSeg{KV + kr0 * 4096 + h * 256, KPE + kr0 * 64, KV + kr0 * 4096 + h * 256 + 128, 4096, 64, 4096, 2048, -1};
                        s1 = KSeg{KV + cr0 * 4096 + h * 256, KPE + cr0 * 64, KV + cr0 * 4096 + h * 256 + 128, 4096, 64, 4096, 256, -1}; nseg = 2; }
                    #if ATTN_NAIVE || ATTN_NAIVE_MLA
                    attn_unit_naive<128, 64, 128>(sc, qs, qb, 3072, 8, ob, 2048, 0, s0, s1, nseg, MLA_SL2, nullptr, wave, lane);
#else
                    attn_unit_mfma<128, 64, 128>(lds, qb, 3072, 8, ob, 2048, 0, s0, s1, nseg, MLA_SL2, nullptr, tid);
#endif
                }
            PH_END
        }
        PH_BEGIN
            pg8::Gemm g{WSP(bf16, WS_AO), (is_win ? WSP(bf16, WS_WOW) : WSP(bf16, WS_WOM)) + (size_t)j * 2048 * 2048, MT, DM, DM}; SOrd S; S.init(MT, DM, Gl, bx);
            EpiResid E{XA_, XB_, X_, MODL_, 2};
            pg8::gemm_phase<EpiResid, SOrd, true, true>(lds, g, S, E, tid);
        PH_END
        PH_BEGIN norm_mod_phase(X_, X_ + (size_t)NCTXR * DM, INP(11) + layer * DM, MODL_, 3, 4, WSP(bf16, WS_H), gw, NGW, lane); PH_END
        PH_BEGIN
            pg8::Gemm g{WSP(bf16, WS_H), WSP(bf16, WS_WGU) + (size_t)layer * 11264 * 2048, MT, 11264, DM}; SOrd S; S.init(MT, 11264, Gl, bx);
            EpiSwiGLU E{WSP(bf16, WS_ACT)};
            pg8::gemm_phase<EpiSwiGLU, SOrd, true, true>(lds, g, S, E, tid);
        PH_END
        PH_BEGIN
            pg8::Gemm g{WSP(bf16, WS_ACT), WSP(bf16, WS_WD) + (size_t)layer * 2048 * 5632, MT, DM, DFF}; SOrd S; S.init(MT, DM, Gl, bx);
            EpiResid E{X_, X_ + (size_t)NCTXR * DM, X_, MODL_, 5};
            pg8::gemm_phase<EpiResid, SOrd, true, true>(lds, g, S, E, tid);
        PH_END
    }
    PH_BEGIN final_norm_phase(WSP(float, WS_X), INP(24), out + O_Y, gw, NGW, lane); PH_END
#undef PH_BEGIN
#undef PH_END
}

extern "C" void kernel_launch(void* const* d_in, const int* in_sizes, int n_in, void* d_out, int out_size, void* d_ws, size_t ws_size, hipStream_t stream) {
    static int grid = 0;
    if (grid == 0) {
        if (n_in != 25 || ws_size < WS_END) { fprintf(stderr, "kernel_launch: expected 25 inputs and >= %zu bytes of workspace; got %d, %zu\n", (size_t)WS_END, n_in, ws_size); grid = -1; return; }
        int dev = 0, cus = 0, per_cu = 0;
        if (hipGetDevice(&dev) != hipSuccess || hipDeviceGetAttribute(&cus, hipDeviceAttributeMultiprocessorCount, dev) != hipSuccess) { grid = -1; return; }
        if (hipFuncSetAttribute((const void*)fwd_kernel, hipFuncAttributeMaxDynamicSharedMemorySize, LDS_BYTES) != hipSuccess) { fprintf(stderr, "kernel_launch: hipFuncSetAttribute failed\n"); grid = -1; return; }
        if (hipOccupancyMaxActiveBlocksPerMultiprocessor(&per_cu, (const void*)fwd_kernel, 512, LDS_BYTES) != hipSuccess || per_cu < 1) { fprintf(stderr, "kernel_launch: occupancy query reports %d blocks per CU\n", per_cu); }
        (void)hipGetLastError();
        grid = cus;
    }
    if (grid < 0) return;
    (void)hipMemsetAsync((char*)d_ws + WS_CTL, 0, CTL_BYTES, stream);
    Params a{};
    for (int i = 0; i < 25; ++i) a.in[i] = (const float*)d_in[i];
    a.out = (float*)d_out; a.ws = (unsigned char*)d_ws;
#if MK_PER_PHASE
    for (int ph = 0; ph < NPHASES; ++ph) { a.lo = ph; a.hi = ph + 1; hipLaunchKernelGGL(fwd_kernel, dim3(grid), dim3(512), LDS_BYTES, stream, a); }
#else
    a.lo = 0; a.hi = NPHASES; hipLaunchKernelGGL(fwd_kernel, dim3(grid), dim3(512), LDS_BYTES, stream, a);
#endif
}
```
